# Optimizing an MI355X kernel written in HIP

```python
import jax, jax.numpy as jnp
from jax import lax
import numpy as np

D_MODEL = 1024
BATCH = 8
SEQ = 4096
DEPTH = 2

GRID_W = 64
CTX_LEN = 256
HEAD_DIM = 64
Q_BLOCK = 128
ROPE_THETA = 10000.0
EPS = 1e-6
M_INIT = -1e30
M_HEADS = 4
M_HEAD_DIM = 128
M_WIDTH = M_HEADS * M_HEAD_DIM
M_CHUNK = 128
CONV_K = 3
G_HEADS = 8
G_KV_HEADS = 2
W_HEADS = 8
W_KV_HEADS = 2
WINDOW = 128
N_HEADS = 8
NB_ROWS = 8
NB_COLS = 16
N_BRANCH = 4
BRANCH_WIDTH = 512
N_EXPERTS = 32
N_GROUPS = 4
EXPERTS_PER_GROUP = N_EXPERTS // N_GROUPS
TOP_K = 2
D_EXPERT = 512
MOE_BLOCK = 128
PROJ_WIDTHS = (M_WIDTH, M_WIDTH, M_WIDTH, M_WIDTH, 4 * M_HEADS,
               G_HEADS * HEAD_DIM, G_KV_HEADS * HEAD_DIM, G_KV_HEADS * HEAD_DIM,
               W_HEADS * HEAD_DIM, W_KV_HEADS * HEAD_DIM, W_KV_HEADS * HEAD_DIM,
               N_HEADS * HEAD_DIM, N_HEADS * HEAD_DIM, N_HEADS * HEAD_DIM,
               N_BRANCH * D_MODEL)
N_PROJ = sum(PROJ_WIDTHS)

kernel_name = 'hybrid_mlstm_gqa_swa_natten_moe_dit_block'


def rms_norm(x, g):
    xf = x.astype(jnp.float32)
    y = xf * lax.rsqrt(jnp.mean(xf * xf, axis=-1, keepdims=True) + EPS)
    return y.astype(x.dtype) * g


def split_projection(p):
    idx, acc = [], 0
    for w in PROJ_WIDTHS[:-1]:
        acc += w
        idx.append(acc)
    return jnp.split(p, idx, axis=-1)


def to_heads(a, n_heads):
    return a.reshape(a.shape[0], a.shape[1], n_heads, HEAD_DIM)


def axial_rope_tables(n_tokens):
    t = jnp.arange(n_tokens, dtype=jnp.int32)
    row = (t // GRID_W).astype(jnp.float32)
    col = (t % GRID_W).astype(jnp.float32)
    n_freq = HEAD_DIM // 4
    inv_freq = ROPE_THETA ** (-jnp.arange(n_freq, dtype=jnp.float32) / n_freq)
    ang = jnp.concatenate([row[:, None] * inv_freq, col[:, None] * inv_freq], axis=-1)
    return jnp.cos(ang), jnp.sin(ang)


def apply_rope(x, cos, sin):
    shp = x.shape
    xf = x.astype(jnp.float32).reshape(shp[:-1] + (shp[-1] // 2, 2))
    x0, x1 = xf[..., 0], xf[..., 1]
    c = cos[None, :, None, :]
    s = sin[None, :, None, :]
    out = jnp.stack([x0 * c - x1 * s, x0 * s + x1 * c], axis=-1)
    return out.reshape(shp).astype(x.dtype)


def ctx_attention(q, k, v, sink=None):
    B, C, Hq, d = q.shape
    Hkv = k.shape[2]
    R = Hq // Hkv
    qg = q.reshape(B, C, Hkv, R, d)
    s = jnp.einsum('bqgrd,bkgd->bgrqk', qg, k).astype(jnp.float32) * d ** -0.5
    if sink is not None:
        sink_col = jnp.broadcast_to(sink.astype(jnp.float32).reshape(1, Hkv, R, 1, 1), (B, Hkv, R, C, 1))
        s = jnp.concatenate([s, sink_col], axis=-1)
    p = jax.nn.softmax(s, axis=-1)[..., :C].astype(v.dtype)
    return jnp.einsum('bgrqk,bkgd->bqgrd', p, v).reshape(B, C, Hq, d)


def global_attention(q, k_all, v_all):
    B, S, Hq, d = q.shape
    Hkv = k_all.shape[2]
    R = Hq // Hkv
    nb = S // Q_BLOCK
    qb = jnp.moveaxis(q.reshape(B, nb, Q_BLOCK, Hkv, R, d), 1, 0)

    def block(qi):
        s = jnp.einsum('bqgrd,bkgd->bgrqk', qi, k_all).astype(jnp.float32) * d ** -0.5
        p = jax.nn.softmax(s, axis=-1).astype(v_all.dtype)
        return jnp.einsum('bgrqk,bkgd->bqgrd', p, v_all)

    o = lax.map(block, qb)
    return jnp.moveaxis(o, 0, 1).reshape(B, S, Hq, d)


def window_attention(q, k, v, kc, vc, sink):
    B, S, Hq, d = q.shape
    Hkv = k.shape[2]
    R = Hq // Hkv
    C = kc.shape[1]
    nb = S // Q_BLOCK
    span = Q_BLOCK + 2 * WINDOW
    pad = ((0, 0), (WINDOW, WINDOW), (0, 0), (0, 0))
    kp = jnp.pad(k, pad)
    vp = jnp.pad(v, pad)
    qb = jnp.moveaxis(q.reshape(B, nb, Q_BLOCK, Hkv, R, d), 1, 0)
    sink_col = jnp.broadcast_to(sink.astype(jnp.float32).reshape(1, Hkv, R, 1, 1), (B, Hkv, R, Q_BLOCK, 1))
    scale = d ** -0.5

    def block(args):
        qi, i = args
        start = i * Q_BLOCK
        ks = lax.dynamic_slice_in_dim(kp, start, span, axis=1)
        vs = lax.dynamic_slice_in_dim(vp, start, span, axis=1)
        qpos = start + jnp.arange(Q_BLOCK)
        kpos = start - WINDOW + jnp.arange(span)
        valid = (jnp.abs(kpos[None, :] - qpos[:, None]) <= WINDOW) & (kpos >= 0)[None, :] & (kpos < S)[None, :]
        s_loc = jnp.einsum('bqgrd,bkgd->bgrqk', qi, ks).astype(jnp.float32) * scale
        s_loc = jnp.where(valid, s_loc, -jnp.inf)
        s_ctx = jnp.einsum('bqgrd,bcgd->bgrqc', qi, kc).astype(jnp.float32) * scale
        p = jax.nn.softmax(jnp.concatenate([s_loc, s_ctx, sink_col], axis=-1), axis=-1).astype(v.dtype)
        return (jnp.einsum('bgrqk,bkgd->bqgrd', p[..., :span], vs)
                + jnp.einsum('bgrqc,bcgd->bqgrd', p[..., span:span + C], vc))

    o = lax.map(block, (qb, jnp.arange(nb)))
    return jnp.moveaxis(o, 0, 1).reshape(B, S, Hq, d)


def neighbourhood_attention(q, k, v, kc, vc, rel_bias):
    B, S, H, d = q.shape
    rows = S // GRID_W
    kh = min(NB_ROWS, rows)
    scale = d ** -0.5
    qg = jnp.moveaxis(q.reshape(B, rows, GRID_W, H, d), 1, 0)
    kg = k.reshape(B, rows, GRID_W, H, d)
    vg = v.reshape(B, rows, GRID_W, H, d)
    col = np.arange(GRID_W)
    col_start = np.clip(col - NB_COLS // 2, 0, GRID_W - NB_COLS)
    col_idx = col_start[:, None] + np.arange(NB_COLS)[None, :]
    dcol = col_idx - col[:, None]
    bias_cols = rel_bias[:, :, dcol + NB_COLS - 1]
    n_loc = kh * NB_COLS

    def block(args):
        qr, r = args
        r0 = jnp.clip(r - kh // 2, 0, rows - kh)
        ks = lax.dynamic_slice_in_dim(kg, r0, kh, axis=1)[:, :, col_idx]
        vs = lax.dynamic_slice_in_dim(vg, r0, kh, axis=1)[:, :, col_idx]
        drow = r0 + jnp.arange(kh) - r
        bias = jnp.moveaxis(bias_cols[:, drow + NB_ROWS - 1], 1, 2)
        s_loc = jnp.einsum('bqhd,bkqjhd->bhqkj', qr, ks).astype(jnp.float32) * scale + bias.astype(jnp.float32)
        s_loc = s_loc.reshape(B, H, GRID_W, n_loc)
        s_ctx = jnp.einsum('bqhd,bchd->bhqc', qr, kc).astype(jnp.float32) * scale
        p = jax.nn.softmax(jnp.concatenate([s_loc, s_ctx], axis=-1), axis=-1).astype(v.dtype)
        p_loc = p[..., :n_loc].reshape(B, H, GRID_W, kh, NB_COLS)
        return (jnp.einsum('bhqkj,bkqjhd->bqhd', p_loc, vs)
                + jnp.einsum('bhqc,bchd->bqhd', p[..., n_loc:], vc))

    o = lax.map(block, (qg, jnp.arange(rows)))
    return jnp.moveaxis(o, 0, 1).reshape(B, S, H, d)


def short_conv(x, w, b):
    y = lax.conv_general_dilated(x, w[:, None, :].astype(x.dtype), window_strides=(1,),
                                 padding=[(CONV_K // 2, CONV_K // 2)],
                                 dimension_numbers=('NWC', 'WIO', 'NWC'),
                                 feature_group_count=x.shape[-1])
    return y + b


def mlstm_inputs(q_raw, k_raw, v_raw, if_raw, conv_w, conv_b, gate_b):
    qk = jax.nn.silu(short_conv(jnp.concatenate([q_raw, k_raw], axis=-1), conv_w, conv_b))
    q, k = jnp.split(qk, 2, axis=-1)
    B, T, _ = q.shape

    def heads(a):
        return jnp.swapaxes(a.reshape(B, T, M_HEADS, M_HEAD_DIM), 1, 2).astype(jnp.float32)

    g = (if_raw.reshape(B, T, 2, 2, M_HEADS) + gate_b).astype(jnp.float32)
    g = jnp.transpose(g, (2, 3, 0, 4, 1))
    log_i = g[:, 0]
    log_f = jax.nn.log_sigmoid(g[:, 1])
    return heads(q), heads(k) * M_HEAD_DIM ** -0.5, heads(v_raw), log_i, log_f


def mlstm_chunk_scan(q, k, v, log_i, log_f, state):
    B, H, T, _ = q.shape
    dv = v.shape[-1]
    L = M_CHUNK
    nc = T // L

    def chunks(a):
        return jnp.moveaxis(a.reshape((B, H, nc, L) + a.shape[3:]), 2, 0)

    tril = jnp.tril(jnp.ones((L, L), dtype=bool))

    def step(carry, xs):
        C, n, m = carry
        qc, kc, vc, ic, fc = xs
        b = jnp.cumsum(fc, axis=-1)
        dmat = jnp.where(tril, b[..., :, None] - b[..., None, :] + ic[..., None, :], -jnp.inf)
        m_inter = b + m[..., None]
        m_t = jnp.maximum(dmat.max(axis=-1), m_inter)
        a = jnp.einsum('bhtd,bhsd->bhts', qc, kc) * jnp.exp(dmat - m_t[..., None])
        inter = jnp.exp(m_inter - m_t)
        num = jnp.einsum('bhts,bhsv->bhtv', a, vc) + inter[..., None] * jnp.einsum('bhtd,bhdv->bhtv', qc, C)
        den = a.sum(axis=-1) + inter * jnp.einsum('bhtd,bhd->bht', qc, n)
        h = num / jnp.maximum(jnp.abs(den), jnp.exp(-m_t))[..., None]
        b_end = b[..., -1]
        g = b_end[..., None] - b + ic
        m_new = jnp.maximum(b_end + m, g.max(axis=-1))
        decay = jnp.exp(b_end + m - m_new)
        wg = jnp.exp(g - m_new[..., None])
        C_new = decay[..., None, None] * C + jnp.einsum('bhs,bhsd,bhsv->bhdv', wg, kc, vc)
        n_new = decay[..., None] * n + jnp.einsum('bhs,bhsd->bhd', wg, kc)
        return (C_new, n_new, m_new), h

    state, hs = lax.scan(step, state, (chunks(q), chunks(k), chunks(v), chunks(log_i), chunks(log_f)))
    return jnp.moveaxis(hs, 0, 2).reshape(B, H, T, dv), state


def mlstm_bidirectional(q, k, v, li, lf, qc, kc, vc, lic, lfc):
    B, H, _, dk = q.shape
    dv = v.shape[-1]
    state0 = (jnp.zeros((B, H, dk, dv), jnp.float32), jnp.zeros((B, H, dk), jnp.float32),
              jnp.full((B, H), M_INIT, jnp.float32))
    outs_l, outs_c = [], []
    for d in range(2):
        rev = (lambda a: jnp.flip(a, axis=2)) if d == 1 else (lambda a: a)
        hc_d, st = mlstm_chunk_scan(rev(qc), rev(kc), rev(vc), rev(lic[d]), rev(lfc[d]), state0)
        hl_d, _ = mlstm_chunk_scan(rev(q), rev(k), rev(v), rev(li[d]), rev(lf[d]), st)
        outs_l.append(rev(hl_d))
        outs_c.append(rev(hc_d))
    return outs_l[0] + outs_l[1], outs_c[0] + outs_c[1]


def mlstm_output(h, o_raw, norm_g):
    h = jnp.swapaxes(h, 1, 2)
    h = h * lax.rsqrt(jnp.mean(h * h, axis=-1, keepdims=True) + EPS)
    B, T = h.shape[:2]
    return (h.reshape(B, T, M_WIDTH).astype(o_raw.dtype) * norm_g) * jax.nn.sigmoid(o_raw)


def merge_branches(branches, gate_raw, w_branch, w_out):
    B, T, _ = gate_raw.shape
    g = jax.nn.sigmoid(gate_raw.reshape(B, T, N_BRANCH, D_MODEL))
    y = g[:, :, 0] * (branches[0] @ w_branch[0])
    for i in range(1, N_BRANCH):
        y = y + g[:, :, i] * (branches[i] @ w_branch[i])
    return y @ w_out


def token_mixer(h, hc, cos, sin, w_in, m_conv_w, m_conv_b, m_gate_b, m_norm_g, g_qnorm, g_knorm,
                w_sink, n_rel_bias, w_branch, w_out, need_ctx):
    B, S, _ = h.shape
    C = hc.shape[1]
    (mq, mk, mv, mo, mif, gq, gk, gv, wq, wk, wv, nq, nk, nv, gate) = split_projection(h @ w_in)
    (mqc, mkc, mvc, moc, mifc, gqc, gkc, gvc, wqc, wkc, wvc, nqc, nkc, nvc, gatec) = split_projection(hc @ w_in)

    a_q, a_k, a_v, a_li, a_lf = mlstm_inputs(mq, mk, mv, mif, m_conv_w, m_conv_b, m_gate_b)
    ac_q, ac_k, ac_v, ac_li, ac_lf = mlstm_inputs(mqc, mkc, mvc, mifc, m_conv_w, m_conv_b, m_gate_b)
    h_lat, h_ctx = mlstm_bidirectional(a_q, a_k, a_v, a_li, a_lf, ac_q, ac_k, ac_v, ac_li, ac_lf)
    out_a = mlstm_output(h_lat, mo, m_norm_g)

    b_q = apply_rope(rms_norm(to_heads(gq, G_HEADS), g_qnorm), cos, sin)
    b_k = apply_rope(rms_norm(to_heads(gk, G_KV_HEADS), g_knorm), cos, sin)
    b_v = to_heads(gv, G_KV_HEADS)
    bc_q = rms_norm(to_heads(gqc, G_HEADS), g_qnorm)
    bc_k = rms_norm(to_heads(gkc, G_KV_HEADS), g_knorm)
    bc_v = to_heads(gvc, G_KV_HEADS)
    out_b = global_attention(b_q, jnp.concatenate([b_k, bc_k], axis=1),
                             jnp.concatenate([b_v, bc_v], axis=1)).reshape(B, S, -1)

    c_q = apply_rope(to_heads(wq, W_HEADS), cos, sin)
    c_k = apply_rope(to_heads(wk, W_KV_HEADS), cos, sin)
    c_v = to_heads(wv, W_KV_HEADS)
    cc_q, cc_k, cc_v = to_heads(wqc, W_HEADS), to_heads(wkc, W_KV_HEADS), to_heads(wvc, W_KV_HEADS)
    out_c = window_attention(c_q, c_k, c_v, cc_k, cc_v, w_sink).reshape(B, S, -1)

    d_q, d_k, d_v = to_heads(nq, N_HEADS), to_heads(nk, N_HEADS), to_heads(nv, N_HEADS)
    dc_q, dc_k, dc_v = to_heads(nqc, N_HEADS), to_heads(nkc, N_HEADS), to_heads(nvc, N_HEADS)
    out_d = neighbourhood_attention(d_q, d_k, d_v, dc_k, dc_v, n_rel_bias).reshape(B, S, -1)

    y = merge_branches([out_a, out_b, out_c, out_d], gate, w_branch, w_out)
    yc = None
    if need_ctx:
        oc_a = mlstm_output(h_ctx, moc, m_norm_g)
        oc_b = ctx_attention(bc_q, bc_k, bc_v).reshape(B, C, -1)
        oc_c = ctx_attention(cc_q, cc_k, cc_v, w_sink).reshape(B, C, -1)
        oc_d = ctx_attention(dc_q, dc_k, dc_v).reshape(B, C, -1)
        yc = merge_branches([oc_a, oc_b, oc_c, oc_d], gatec, w_branch, w_out)
    return y, yc


def moe_ffn(t, w_router, router_bias, e_gate, e_up, e_down):
    T, D = t.shape
    scores = jax.nn.sigmoid((t @ w_router).astype(jnp.float32))
    sel = (scores + router_bias.astype(jnp.float32)).reshape(T, N_GROUPS, EXPERTS_PER_GROUP)
    group_score = lax.top_k(sel, TOP_K)[0].sum(axis=-1)
    grp = jnp.argmax(group_score, axis=-1)
    in_group = jnp.take_along_axis(sel, grp[:, None, None], axis=1)[:, 0]
    _, local = lax.top_k(in_group, TOP_K)
    expert = grp[:, None] * EXPERTS_PER_GROUP + local
    w = jnp.take_along_axis(scores, expert, axis=1)
    w = w / w.sum(axis=-1, keepdims=True)

    n_assign = T * TOP_K
    e_flat = expert.reshape(-1)
    tok = jnp.repeat(jnp.arange(T, dtype=jnp.int32), TOP_K)
    w_flat = w.reshape(-1)
    order = jnp.argsort(e_flat)
    e_s, tok_s, w_s = e_flat[order], tok[order], w_flat[order]
    counts = jnp.bincount(e_flat, length=N_EXPERTS)
    starts = jnp.cumsum(counts) - counts
    padded = ((counts + MOE_BLOCK - 1) // MOE_BLOCK) * MOE_BLOCK
    pends = jnp.cumsum(padded)
    pstarts = pends - padded
    dest = pstarts[e_s] + (jnp.arange(n_assign) - starts[e_s])
    nblk = -(-(n_assign + N_EXPERTS * (MOE_BLOCK - 1)) // MOE_BLOCK)
    cap = nblk * MOE_BLOCK
    slot_tok = jnp.full((cap,), T, dtype=jnp.int32).at[dest].set(tok_s)
    slot_w = jnp.zeros((cap,), jnp.float32).at[dest].set(w_s)
    blk_e = jnp.minimum(jnp.searchsorted(pends, jnp.arange(nblk) * MOE_BLOCK, side='right'), N_EXPERTS - 1)
    t_pad = jnp.concatenate([t, jnp.zeros((1, D), t.dtype)], axis=0)
    xs = t_pad[slot_tok].reshape(nblk, MOE_BLOCK, D)

    def expert_block(args):
        xb, e = args
        hmid = jax.nn.silu(xb @ e_gate[e]) * (xb @ e_up[e])
        return hmid @ e_down[e]

    ys = lax.map(expert_block, (xs, blk_e)).reshape(cap, D)
    out = jnp.zeros((T + 1, D), ys.dtype).at[slot_tok].add(ys * slot_w[:, None].astype(ys.dtype))
    return out[:T]


def setup_inputs(seed: int = 0) -> dict:
    key = jax.random.key(seed)
    ks = jax.random.split(key, 32)
    f32 = jnp.float32
    L, D = DEPTH, D_MODEL

    def nrm(k, shape, scale):
        return jax.random.normal(k, shape, f32) * scale

    gate_base = jnp.array([-1.0, 3.0], f32).reshape(1, 1, 2, 1)
    return {
        'x': nrm(ks[0], (BATCH, SEQ, D), 1.0),
        'c': nrm(ks[1], (BATCH, D), 1.0),
        'ctx': nrm(ks[2], (BATCH, CTX_LEN, D), 1.0),
        'c_ctx': nrm(ks[3], (D,), 1.0),
        'w_mod': nrm(ks[4], (L, D, 6 * D), 0.5 * D ** -0.5),
        'b_mod': nrm(ks[5], (L, 6 * D), 0.02),
        'norm1_g': 1.0 + nrm(ks[6], (L, D), 0.05),
        'norm2_g': 1.0 + nrm(ks[7], (L, D), 0.05),
        'w_in': nrm(ks[8], (L, D, N_PROJ), D ** -0.5),
        'm_conv_w': nrm(ks[9], (L, CONV_K, 2 * M_WIDTH), CONV_K ** -0.5),
        'm_conv_b': nrm(ks[10], (L, 2 * M_WIDTH), 0.02),
        'm_gate_b': gate_base + nrm(ks[11], (L, 2, 2, M_HEADS), 0.2),
        'm_norm_g': 1.0 + nrm(ks[12], (L, M_WIDTH), 0.05),
        'g_qnorm': 1.0 + nrm(ks[13], (L, HEAD_DIM), 0.05),
        'g_knorm': 1.0 + nrm(ks[14], (L, HEAD_DIM), 0.05),
        'w_sink': nrm(ks[15], (L, W_HEADS), 0.5),
        'n_rel_bias': nrm(ks[16], (L, N_HEADS, 2 * NB_ROWS - 1, 2 * NB_COLS - 1), 0.5),
        'w_branch': nrm(ks[17], (L, N_BRANCH, BRANCH_WIDTH, D), BRANCH_WIDTH ** -0.5),
        'w_out': nrm(ks[18], (L, D, D), D ** -0.5),
        'w_router': nrm(ks[19], (D, N_EXPERTS), D ** -0.5),
        'router_bias': nrm(ks[20], (N_EXPERTS,), 0.01),
        'e_gate': nrm(ks[21], (L, N_EXPERTS, D, D_EXPERT), D ** -0.5),
        'e_up': nrm(ks[22], (L, N_EXPERTS, D, D_EXPERT), D ** -0.5),
        'e_down': nrm(ks[23], (L, N_EXPERTS, D_EXPERT, D), D_EXPERT ** -0.5),
        'final_g': 1.0 + nrm(ks[24], (D,), 0.05),
    }


def reference(x, c, ctx, c_ctx, w_mod, b_mod, norm1_g, norm2_g, w_in, m_conv_w, m_conv_b, m_gate_b,
              m_norm_g, g_qnorm, g_knorm, w_sink, n_rel_bias, w_branch, w_out, w_router, router_bias,
              e_gate, e_up, e_down, final_g):
    B, S, D = x.shape
    cos, sin = axial_rope_tables(S)
    xc = ctx
    for l in range(DEPTH):
        need_ctx = l < DEPTH - 1
        mod = jax.nn.silu(c) @ w_mod[l] + b_mod[l]
        sh1, sc1, ga1, sh2, sc2, ga2 = jnp.split(mod[:, None, :], 6, axis=-1)
        modc = jax.nn.silu(c_ctx) @ w_mod[l] + b_mod[l]
        csh1, csc1, cga1, csh2, csc2, cga2 = jnp.split(modc, 6)

        h = rms_norm(x, norm1_g[l]) * (1 + sc1) + sh1
        hc = rms_norm(xc, norm1_g[l]) * (1 + csc1) + csh1
        y, yc = token_mixer(h, hc, cos, sin, w_in[l], m_conv_w[l], m_conv_b[l], m_gate_b[l], m_norm_g[l],
                            g_qnorm[l], g_knorm[l], w_sink[l], n_rel_bias[l], w_branch[l], w_out[l], need_ctx)
        x = x + ga1 * y
        h2 = rms_norm(x, norm2_g[l]) * (1 + sc2) + sh2
        tokens = h2.reshape(B * S, D)
        if need_ctx:
            xc = xc + cga1 * yc
            hc2 = rms_norm(xc, norm2_g[l]) * (1 + csc2) + csh2
            tokens = jnp.concatenate([tokens, hc2.reshape(-1, D)], axis=0)
        f = moe_ffn(tokens, w_router, router_bias, e_gate[l], e_up[l], e_down[l])
        x = x + ga2 * f[:B * S].reshape(B, S, D)
        if need_ctx:
            xc = xc + cga2 * f[B * S:].reshape(B, -1, D)
    return rms_norm(x, final_g)
```

```cpp
#include <hip/hip_runtime.h>
#include <stdint.h>
#include <stdio.h>

#define LAS __attribute__((address_space(3)))
#define DI __device__ __forceinline__
typedef unsigned short bf16_t;
typedef short bf16x8 __attribute__((ext_vector_type(8)));
typedef short s16x4 __attribute__((ext_vector_type(4)));
typedef float f32x4 __attribute__((ext_vector_type(4)));
typedef float f32x2 __attribute__((ext_vector_type(2)));
typedef float f32x16 __attribute__((ext_vector_type(16)));
typedef unsigned u32x4 __attribute__((ext_vector_type(4)));
typedef unsigned u32x2 __attribute__((ext_vector_type(2)));
typedef __bf16 bfx2 __attribute__((ext_vector_type(2)));

#ifndef N_LAUNCH_PER_STEP
#define N_LAUNCH_PER_STEP 0
#endif

constexpr int D = 1024, NB = 8, SEQ = 4096, CTX = 256, TPB = 4352, T = NB * TPB, NRT = T / 256;
constexpr int NPA = 5120, NPG = 4096, NPROJ = NPA + NPG, WIN_LD = 9232;
constexpr int C_MQ = 0, C_MK = 512, C_MV = 1024, C_MO = 1536, C_GQ = 2048, C_GK = 2560, C_GV = 2688, C_WQ = 2816, C_WK = 3328, C_WV = 3456, C_NQ = 3584, C_NK = 4096, C_NV = 4608;
constexpr int CAP = 77824, NE = 32;
constexpr float EPS = 1e-6f;
constexpr int NTHR = 512;
constexpr int LDS_BYTES = 147456;
constexpr int MISC_OFF = 131072;

DI float bf2f(bf16_t v) { return __uint_as_float(((unsigned)v) << 16); }
DI float bflo(unsigned u) { return __uint_as_float(u << 16); }
DI float bfhi(unsigned u) { return __uint_as_float(u & 0xffff0000u); }
DI unsigned pk2(float lo, float hi) { f32x2 v = {lo, hi}; return __builtin_bit_cast(unsigned, __builtin_convertvector(v, bfx2)); }
typedef _Float16 hfx2 __attribute__((ext_vector_type(2)));
DI unsigned pkh2(float lo, float hi) { f32x2 v = {lo, hi}; return __builtin_bit_cast(unsigned, __builtin_convertvector(v, hfx2)); }
DI f32x4 hf4(u32x2 w) { const hfx2 a = __builtin_bit_cast(hfx2, w.x), b = __builtin_bit_cast(hfx2, w.y); return (f32x4){(float)a[0], (float)a[1], (float)b[0], (float)b[1]}; }
DI unsigned pk_fp8x4(float a, float b, float c, float d) {
    a = fminf(fmaxf(a, -448.f), 448.f); b = fminf(fmaxf(b, -448.f), 448.f); c = fminf(fmaxf(c, -448.f), 448.f); d = fminf(fmaxf(d, -448.f), 448.f);
    int p = 0; p = __builtin_amdgcn_cvt_pk_fp8_f32(a, b, p, false); p = __builtin_amdgcn_cvt_pk_fp8_f32(c, d, p, true); return (unsigned)p;
}
DI bf16_t f2bf(float x) { return (bf16_t)(pk2(x, 0.f) & 0xffffu); }
DI float rcpf_(float x) { return __builtin_amdgcn_rcpf(x); }
DI float sigmoidf_(float x) { return rcpf_(1.f + __expf(-x)); }
DI float siluf_(float x) { return x * rcpf_(1.f + __expf(-x)); }
DI float wave_sum(float v) { for (int o = 32; o >= 1; o >>= 1) v += __shfl_xor(v, o); return v; }
DI f32x16 mfma32(bf16x8 a, bf16x8 b, f32x16 c) { return __builtin_amdgcn_mfma_f32_32x32x16_bf16(a, b, c, 0, 0, 0); }
DI bf16x8 pack8(float a0, float a1, float a2, float a3, float a4, float a5, float a6, float a7) {
    u32x4 p; p.x = pk2(a0, a1); p.y = pk2(a2, a3); p.z = pk2(a4, a5); p.w = pk2(a6, a7); return __builtin_bit_cast(bf16x8, p);
}
DI int crow(int reg, int h) { return (reg & 3) + 8 * (reg >> 2) + 4 * h; }

constexpr size_t al256(size_t x) { return (x + 255) & ~(size_t)255; }
constexpr size_t OFF_ctl = 0;
constexpr size_t OFF_modv = OFF_ctl + 65536;
constexpr size_t OFF_rope = OFF_modv + al256((size_t)2 * 9 * 6144 * 4);
constexpr size_t OFF_gI = OFF_rope + 8192;
constexpr size_t OFF_gF = OFF_gI + al256((size_t)2 * NB * 4 * TPB * 4);
constexpr size_t OFF_tokE = OFF_gF + al256((size_t)2 * NB * 4 * TPB * 4);
constexpr size_t OFF_tokS = OFF_tokE + al256((size_t)T * 2 * 4);
constexpr size_t OFF_tokW = OFF_tokS + al256((size_t)T * 2 * 4);
constexpr size_t OFF_halo = OFF_tokW + al256((size_t)T * 2 * 4);
constexpr size_t OFF_xc = OFF_halo + al256((size_t)(T / 2 / 64) * 4 * 1024 * 2);
constexpr size_t OFF_win = OFF_xc + (size_t)NB * CTX * D * 4;
constexpr size_t OFF_wbr = OFF_win + (size_t)2 * NPROJ * D * 2;
constexpr size_t OFF_wout = OFF_wbr + (size_t)2 * 1024 * 2048 * 2;
constexpr size_t OFF_wgu = OFF_wout + (size_t)2 * 1024 * 1024 * 2;
constexpr size_t OFF_wdn = OFF_wgu + (size_t)NE * 1024 * 1024;
constexpr size_t OFF_win8 = OFF_wdn + (size_t)NE * 1024 * 512;
constexpr size_t OFF_h = OFF_win8 + (size_t)2 * NPROJ * D;
constexpr size_t OFF_h8in = OFF_h + (size_t)T * D * 2;
constexpr size_t OFF_u = OFF_h8in + (size_t)T * D;
constexpr size_t OFF_xs = OFF_u;
constexpr size_t OFF_hmid = OFF_xs + (size_t)CAP * 1024;
constexpr size_t OFF_ys = OFF_hmid + (size_t)CAP * 512;
constexpr size_t OFF_h8 = OFF_ys + (size_t)CAP * 1024 * 2;
constexpr size_t OFF_moe_end = OFF_h8 + (size_t)T * 1024;
__host__ __device__ inline size_t uo_projA(size_t rs) { return OFF_u; }
__host__ __device__ inline size_t uo_projG(size_t rs) { return OFF_u + rs * NPA * 2; }
__host__ __device__ inline size_t uo_bcat(size_t rs) { return OFF_u + rs * (NPA + NPG) * 2; }
__host__ __device__ inline size_t uo_hpart(size_t rs) { return OFF_u + rs * (NPA + NPG + 2048) * 2; }
__host__ __device__ inline size_t uo_end(size_t rs) { return OFF_u + rs * (NPA + NPG + 2048 + 1024) * 2; }
inline size_t ws_need(int nsplit) { const size_t a = uo_end((size_t)T / nsplit); return a > OFF_moe_end ? a : OFF_moe_end; }
#define XB_TMO      128
#define XB_XCNT(j)  (256  + 64 * (j))
#define XB_XSUB(j)  (1280 + 64 * (j))
#define XB_XGEN(j)  (2304 + 64 * (j))
#define XB_TOP      3328
#define XB_TOPGEN   3392
#define XCD_BAR_WORDS 3456
#define XB_SPIN_CAP (1u << 22)
constexpr int CW_QUEUE = 4096;
constexpr int CW_CNT = 12288;

DI unsigned xb_ld(unsigned* p)              { return __hip_atomic_load(p, __ATOMIC_RELAXED, __HIP_MEMORY_SCOPE_AGENT); }
DI unsigned xb_add(unsigned* p, unsigned v) { return __hip_atomic_fetch_add(p, v, __ATOMIC_RELAXED, __HIP_MEMORY_SCOPE_AGENT); }
DI unsigned xb_xcc_id() { return (unsigned)__builtin_amdgcn_s_getreg((3 << 11) | 20) & 0xFu; }
#define XB_SPIN(cond, bar) do { unsigned _sp = 0; while (cond) { __builtin_amdgcn_s_sleep(1); \
    if ((++_sp & 255u) == 0u) { if (xb_ld(&(bar)[XB_TMO])) break; if (_sp > XB_SPIN_CAP) { atomicAdd(&(bar)[XB_TMO], 1u); break; } } } } while (0)
struct XcdBarrier { unsigned* bar; unsigned x; volatile LAS unsigned* st; };
DI XcdBarrier xcd_barrier_post(unsigned* bar, volatile LAS unsigned* st) {
    XcdBarrier b; b.bar = bar; b.x = xb_xcc_id(); b.st = st;
    if (threadIdx.x == 0) (void)xb_add(&bar[XB_XCNT(b.x)], 1u);
    return b;
}
DI void xcd_barrier_complete(unsigned* bar, unsigned x, unsigned& nloc, unsigned& nx) {
    const unsigned G = gridDim.x * gridDim.y * gridDim.z;
    unsigned sum, cnt, mine, sp = 0u;
    for (;;) {
        sum = 0u; cnt = 0u; mine = 0u;
#pragma unroll
        for (unsigned j = 0; j < 16; ++j) { const unsigned c = xb_ld(&bar[XB_XCNT(j)]); sum += c; cnt += (c > 0u) ? 1u : 0u; mine = (j == x) ? c : mine; }
        if (sum == G) break;
        __builtin_amdgcn_s_sleep(1);
        if ((++sp & 255u) == 0u) { if (xb_ld(&bar[XB_TMO])) break; if (sp > XB_SPIN_CAP) { atomicAdd(&bar[XB_TMO], 1u); break; } }
    }
    nloc = mine > 0u ? mine : 1u; nx = cnt > 0u ? cnt : 1u;
}
DI void xcd_barrier(const XcdBarrier& b, const int tid) {
    asm volatile("s_waitcnt vmcnt(0)" ::: "memory");
    __syncthreads();
    if (tid == 0) {
        unsigned* bar = b.bar;
        __builtin_amdgcn_s_waitcnt(0);
        unsigned nloc = b.st[0], nx = b.st[1];
        if (nloc == 0u) { xcd_barrier_complete(bar, b.x, nloc, nx); b.st[0] = nloc; b.st[1] = nx; }
        const unsigned old = xb_add(&bar[XB_XSUB(b.x)], 1u);
        const unsigned gen = old / nloc;
        if (old + 1u == (gen + 1u) * nloc) {
            __builtin_amdgcn_fence(__ATOMIC_RELEASE, "agent");
            asm volatile("s_waitcnt vmcnt(0)" ::: "memory");
            const unsigned og = xb_add(&bar[XB_TOP], 1u);
            const unsigned tg = og / nx;
            if (og + 1u == (tg + 1u) * nx) xb_add(&bar[XB_TOPGEN], 1u);
            else XB_SPIN(xb_ld(&bar[XB_TOPGEN]) == tg, bar);
            __builtin_amdgcn_fence(__ATOMIC_ACQUIRE, "agent");
            xb_add(&bar[XB_XGEN(b.x)], 1u);
            asm volatile("s_waitcnt vmcnt(0)" ::: "memory");
        } else {
            XB_SPIN(xb_ld(&bar[XB_XGEN(b.x)]) == gen, bar);
            __builtin_amdgcn_fence(__ATOMIC_ACQUIRE, "agent");
            asm volatile("s_waitcnt vmcnt(0)" ::: "memory");
        }
    }
    __syncthreads();
}

struct Params { const float* in[25]; float* out; unsigned char* ws; int nsplit, lsplit, step_lo, step_hi; };
typedef __attribute__((address_space(4))) Params ParamsK; typedef const ParamsK* KPtr;
struct Ctx {
    KPtr kp; float* out; unsigned char* ws;
    LAS unsigned char* lds; int tid, lane, wv, G, bid, nsplit, rs  , nbs  ;
    unsigned* ctl;
};
enum { I_X = 0, I_C, I_CTX, I_CCTX, I_WMOD, I_BMOD, I_N1G, I_N2G, I_WIN, I_CONVW, I_CONVB, I_GATEB, I_MNORMG, I_QNORM, I_KNORM, I_SINK, I_RELB, I_WBR, I_WOUT, I_WR, I_RB, I_EG, I_EU, I_ED, I_FING };

namespace pg8 {
constexpr int BM = 256, BK = 64, HALF = 128, HTB = HALF * BK * 2, STAGE_BYTES = 8 * HTB, NXCD = 8, WGM = 8;
DI int lds_byte(int r, int c) { const int st = (r >> 4) * 2 + (c >> 5), rr = r & 15, cc = c & 31, ob = rr * 64 + cc * 2; return st * 1024 + (ob ^ (((ob >> 9) & 1) << 5)); }
DI void stage_rc(int b, int& R, int& C) { const int st = b / 1024, sb = b % 1024, swz = sb ^ (((sb >> 9) & 1) << 5); R = (st >> 1) * 16 + swz / 64; C = (st & 1) * 32 + (swz % 64) / 2; }
DI int perm32(int rho) { const int n = rho >> 4, i = rho & 15; return 8 * (i >> 2) + 4 * n + (i & 3); }
struct Unit { int pm, pn, ko, aux, kt; };
struct Gemm { const bf16_t* A; const bf16_t* Bt; int K, lda, ldb; };
DI void tile_order(int L, int nM, int nN, int& pm, int& pn) {
    const int nwg = nM * nN; int wgid = L;
    { const int q = nwg / NXCD, r = nwg % NXCD, xcd = wgid % NXCD, off = wgid / NXCD; wgid = (xcd < r ? xcd * (q + 1) : r * (q + 1) + (xcd - r) * q) + off; }
    const int nig = WGM * nN, gid = wgid / nig, fm = gid * WGM, gsz = (nM - fm) < WGM ? (nM - fm) : WGM;
    pm = fm + ((wgid % nig) % gsz); pn = (wgid % nig) / gsz;
}
template <class Epi, class Sched>
DI void gemm_phase(LAS unsigned char* lds, const int tid, const Gemm g, const Sched& S, const Epi& E) {
    const int wid = __builtin_amdgcn_readfirstlane(tid >> 6), lane = tid & 63, wr = wid >> 2, wc = wid & 3, fr = lane & 15, fq = lane >> 4;
    int K = g.K; asm volatile("" : "+s"(K)); const int nt = K / BK;
    unsigned voffA[2], voffB[2];
#pragma unroll
    for (int i = 0; i < 2; ++i) { int R, C; stage_rc(tid * 16 + i * 8192, R, C); const int Rb = Epi::PERM ? ((R & ~31) + perm32(R & 31)) : R;
        voffA[i] = (unsigned)(R * g.lda + C) * 2u; voffB[i] = (unsigned)(Rb * g.ldb + C) * 2u; }
    const size_t kstep = (size_t)(BK * 2);
    const size_t hstepA = (size_t)HALF * g.lda * 2, hstepB = (size_t)HALF * g.ldb * 2;
    const size_t tstepA = 2 * hstepA, tstepB = 2 * hstepB;
    const unsigned ldsw = (unsigned)wid * 1024u;
    const int aoff = lds_byte(wr * 64 + fr, fq * 8), boff = lds_byte(wc * 32 + fr, fq * 8);
#define PG8_SA(b, h) (((b) * 2 + (h)) * HTB)
#define PG8_SB(b, h) ((4 + (b) * 2 + (h)) * HTB)
#define PG8_STAGE(bufoff, gbase, voff) do { _Pragma("unroll") for (int _i = 0; _i < 2; ++_i) \
        __builtin_amdgcn_global_load_lds((const unsigned*)((const char*)(gbase) + (voff)[_i]), (LAS unsigned*)(lds + (bufoff) + ldsw + _i * 8192), 16, 0, 0); } while (0)
#define PG8_LDA(dst, b, h) do { _Pragma("unroll") for (int m = 0; m < 4; ++m) _Pragma("unroll") for (int k = 0; k < 2; ++k) dst[m][k] = *(const LAS bf16x8*)(lds + PG8_SA(b, h) + aoff + m * 2048 + k * 1024); } while (0)
#define PG8_LDB(dst, b, h) do { _Pragma("unroll") for (int n = 0; n < 2; ++n) _Pragma("unroll") for (int k = 0; k < 2; ++k) dst[n][k] = *(const LAS bf16x8*)(lds + PG8_SB(b, h) + boff + n * 2048 + k * 1024); } while (0)
#define PG8_MMA(ai, bj, At, Bt) do { __builtin_amdgcn_s_setprio(1); _Pragma("unroll") for (int m = 0; m < 4; ++m) _Pragma("unroll") for (int n = 0; n < 2; ++n) _Pragma("unroll") for (int k = 0; k < 2; ++k) \
        acc[ai][bj][m][n] = __builtin_amdgcn_mfma_f32_16x16x32_bf16(Bt[n][k], At[m][k], acc[ai][bj][m][n], 0, 0, 0); __builtin_amdgcn_s_setprio(0); } while (0)
#define PG8_WAIT_V(n) asm volatile("s_waitcnt vmcnt(" #n ")" ::: "memory")
#define PG8_WAIT_L(n) asm volatile("s_waitcnt lgkmcnt(" #n ")" ::: "memory")
#define PG8_BAR __builtin_amdgcn_s_barrier()
#define PG8_SCHED __builtin_amdgcn_sched_barrier(0)
    Unit cur, nxt; int ui = 0;
    if (!S.next(0, cur)) return;
    f32x4 acc[2][2][4][2];
#pragma unroll
    for (int a = 0; a < 2; ++a)
#pragma unroll
        for (int b = 0; b < 2; ++b)
#pragma unroll
            for (int m = 0; m < 4; ++m)
#pragma unroll
                for (int n = 0; n < 2; ++n) acc[a][b][m][n] = (f32x4){0.f, 0.f, 0.f, 0.f};
    bf16x8 At[4][2], B0[2][2], B1[2][2];
    const char* cA = (const char*)g.A + (size_t)cur.pm * tstepA + (size_t)cur.ko * 2; const char* cB = (const char*)g.Bt + (size_t)cur.pn * tstepB + (size_t)cur.ko * 2;
    PG8_STAGE(PG8_SB(0, 0), cB, voffB); PG8_STAGE(PG8_SA(0, 0), cA, voffA); PG8_STAGE(PG8_SB(0, 1), cB + hstepB, voffB); PG8_STAGE(PG8_SA(0, 1), cA + hstepA, voffA);
    if (wr == 1) PG8_BAR;
    PG8_WAIT_V(4); PG8_BAR;
    PG8_STAGE(PG8_SB(1, 0), cB + kstep, voffB); PG8_STAGE(PG8_SA(1, 0), cA + kstep, voffA); PG8_STAGE(PG8_SB(1, 1), cB + hstepB + kstep, voffB);
    PG8_WAIT_V(6); PG8_BAR;
    for (;;) {
        const bool has_next = S.next(ui + 1, nxt);
        const char* nA = has_next ? (const char*)g.A + (size_t)nxt.pm * tstepA + (size_t)nxt.ko * 2 : cA; const char* nB = has_next ? (const char*)g.Bt + (size_t)nxt.pn * tstepB + (size_t)nxt.ko * 2 : cB;
#pragma unroll 1
        for (int t = 0; t < nt; t += 2) {
            if constexpr (Epi::HOOK_T > 0) { if (t > 0 && (t & (Epi::HOOK_T - 1)) == 0) E.mid(acc, cur, t / Epi::HOOK_T, wr, wc, fr, fq); }
            const bool last = (t == nt - 2);
            const char* a1 = cA + (size_t)(t + 1) * kstep;
            const char* a2 = last ? nA : cA + (size_t)(t + 2) * kstep; const char* b2 = last ? nB : cB + (size_t)(t + 2) * kstep;
            const char* a3 = a2 + kstep; const char* b3 = b2 + kstep;
            PG8_LDB(B0, 0, 0); PG8_SCHED; PG8_LDA(At, 0, 0); PG8_STAGE(PG8_SA(1, 1), a1 + hstepA, voffA);
            PG8_WAIT_L(8); PG8_BAR; PG8_WAIT_L(0); PG8_MMA(0, 0, At, B0); PG8_BAR; PG8_SCHED;
            PG8_LDB(B1, 0, 1); PG8_STAGE(PG8_SB(0, 0), b2, voffB);
            PG8_BAR; PG8_WAIT_L(0); PG8_MMA(0, 1, At, B1); PG8_BAR;
            PG8_LDA(At, 0, 1); PG8_STAGE(PG8_SA(0, 0), a2, voffA);
            PG8_BAR; PG8_WAIT_L(0); PG8_MMA(1, 0, At, B0); PG8_BAR; PG8_SCHED;
            PG8_STAGE(PG8_SB(0, 1), b2 + hstepB, voffB);
            PG8_WAIT_V(6); PG8_BAR; PG8_MMA(1, 1, At, B1); PG8_BAR;
            PG8_LDB(B0, 1, 0); PG8_SCHED; PG8_LDA(At, 1, 0); PG8_STAGE(PG8_SA(0, 1), a2 + hstepA, voffA);
            PG8_WAIT_L(8); PG8_BAR; PG8_WAIT_L(0); PG8_MMA(0, 0, At, B0); PG8_BAR; PG8_SCHED;
            PG8_LDB(B1, 1, 1); PG8_STAGE(PG8_SB(1, 0), b3, voffB);
            PG8_BAR; PG8_WAIT_L(0); PG8_MMA(0, 1, At, B1); PG8_BAR;
            PG8_LDA(At, 1, 1); PG8_STAGE(PG8_SA(1, 0), a3, voffA);
            PG8_BAR; PG8_WAIT_L(0); PG8_MMA(1, 0, At, B0); PG8_BAR; PG8_SCHED;
            PG8_STAGE(PG8_SB(1, 1), b3 + hstepB, voffB);
            PG8_WAIT_V(6); PG8_BAR; PG8_MMA(1, 1, At, B1); PG8_BAR;
        }
        E(acc, cur, wr, wc, fr, fq);
        if (!has_next) break;
#pragma unroll
        for (int a = 0; a < 2; ++a)
#pragma unroll
            for (int b = 0; b < 2; ++b)
#pragma unroll
                for (int m = 0; m < 4; ++m)
#pragma unroll
                    for (int n = 0; n < 2; ++n) acc[a][b][m][n] = (f32x4){0.f, 0.f, 0.f, 0.f};
        cur = nxt; cA = nA; cB = nB; ++ui;
    }
    PG8_WAIT_V(0);
    if (wr == 0) PG8_BAR;
    PG8_BAR;
#undef PG8_SA
#undef PG8_SB
#undef PG8_STAGE
#undef PG8_LDA
#undef PG8_LDB
#undef PG8_MMA
#undef PG8_WAIT_V
#undef PG8_WAIT_L
#undef PG8_BAR
#undef PG8_SCHED
}
typedef int v8i32 __attribute__((ext_vector_type(8)));
typedef int i32x4 __attribute__((ext_vector_type(4)));
struct Gemm8 { const unsigned char* A; const unsigned char* Bt; int K, lda, ldb; int scale_a, scale_b; };
template <class Epi, class Sched>
DI void gemm_phase8(LAS unsigned char* lds, const int tid, const Gemm8 g, const Sched& S, const Epi& E) {
    const int wid = __builtin_amdgcn_readfirstlane(tid >> 6), lane = tid & 63, wr = wid >> 2, wc = wid & 3, fr = lane & 15, fq = lane >> 4;
    int K = g.K; asm volatile("" : "+s"(K)); const int nt = K / 128;
    unsigned voffA[2], voffB[2];
#pragma unroll
    for (int i = 0; i < 2; ++i) { int R, C; stage_rc(tid * 16 + i * 8192, R, C); const int Rb = Epi::PERM ? ((R & ~31) + perm32(R & 31)) : R;
        voffA[i] = (unsigned)(R * g.lda + C * 2); voffB[i] = (unsigned)(Rb * g.ldb + C * 2); }
    const size_t kstep = (size_t)(BK * 2);
    const size_t hstepA = (size_t)HALF * g.lda, hstepB = (size_t)HALF * g.ldb;
    const size_t tstepA = 2 * hstepA, tstepB = 2 * hstepB;
    const unsigned ldsw = (unsigned)wid * 1024u;
    const int aoff = lds_byte(wr * 64 + fr, fq * 8), boff = lds_byte(wc * 32 + fr, fq * 8);
#define PG8_SA(b, h) (((b) * 2 + (h)) * HTB)
#define PG8_SB(b, h) ((4 + (b) * 2 + (h)) * HTB)
#define PG8_STAGE(bufoff, gbase, voff) do { _Pragma("unroll") for (int _i = 0; _i < 2; ++_i) \
        __builtin_amdgcn_global_load_lds((const unsigned*)((const char*)(gbase) + (voff)[_i]), (LAS unsigned*)(lds + (bufoff) + ldsw + _i * 8192), 16, 0, 0); } while (0)
#define PG8_LD32(p) __builtin_shufflevector(*(const LAS i32x4*)(p), *(const LAS i32x4*)((p) + 1024), 0, 1, 2, 3, 4, 5, 6, 7)
#define PG8_LDA(dst, b, h) do { _Pragma("unroll") for (int m = 0; m < 4; ++m) dst[m] = PG8_LD32(lds + PG8_SA(b, h) + aoff + m * 2048); } while (0)
#define PG8_LDB(dst, b, h) do { _Pragma("unroll") for (int n = 0; n < 2; ++n) dst[n] = PG8_LD32(lds + PG8_SB(b, h) + boff + n * 2048); } while (0)
#define PG8_MMA(ai, bj, At, Bt) do { __builtin_amdgcn_s_setprio(1); _Pragma("unroll") for (int m = 0; m < 4; ++m) _Pragma("unroll") for (int n = 0; n < 2; ++n) \
        asm volatile("v_mfma_scale_f32_16x16x128_f8f6f4 %0, %1, %2, %0, %3, %4 op_sel_hi:[0,0,0]" : "+v"(acc[ai][bj][m][n]) : "v"(Bt[n]), "v"(At[m]), "v"(sc_b), "v"(sc_a)); __builtin_amdgcn_s_setprio(0); } while (0)
#define PG8_WAIT_V(n) asm volatile("s_waitcnt vmcnt(" #n ")" ::: "memory")
#define PG8_WAIT_L(n) asm volatile("s_waitcnt lgkmcnt(" #n ")" ::: "memory")
#define PG8_BAR __builtin_amdgcn_s_barrier()
#define PG8_SCHED __builtin_amdgcn_sched_barrier(0)
    Unit cur, nxt; int ui = 0;
    if (!S.next(0, cur)) return;
    constexpr bool GA = Sched::GATHER;
    unsigned vgC[2][2] = {{0u, 0u}, {0u, 0u}}, vgN[2][2] = {{0u, 0u}, {0u, 0u}};
#define PG8_GOFFS(u_, vg_) do { _Pragma("unroll") for (int _h = 0; _h < 2; ++_h) _Pragma("unroll") for (int _i = 0; _i < 2; ++_i) { int R_, C_; stage_rc(tid * 16 + _i * 8192, R_, C_); \
        vg_[_h][_i] = (unsigned)S.row_of((u_).pm * 256 + _h * 128 + R_) * (unsigned)g.lda + (unsigned)(C_ * 2); } } while (0)
#define PG8_STAGE2(bufoff, gbase, v0_, v1_) do { \
        __builtin_amdgcn_global_load_lds((const unsigned*)((const char*)(gbase) + (v0_)), (LAS unsigned*)(lds + (bufoff) + ldsw), 16, 0, 0); \
        __builtin_amdgcn_global_load_lds((const unsigned*)((const char*)(gbase) + (v1_)), (LAS unsigned*)(lds + (bufoff) + ldsw + 8192), 16, 0, 0); } while (0)
    if constexpr (GA) PG8_GOFFS(cur, vgC);
    f32x4 acc[2][2][4][2];
#pragma unroll
    for (int a = 0; a < 2; ++a)
#pragma unroll
        for (int b = 0; b < 2; ++b)
#pragma unroll
            for (int m = 0; m < 4; ++m)
#pragma unroll
                for (int n = 0; n < 2; ++n) acc[a][b][m][n] = (f32x4){0.f, 0.f, 0.f, 0.f};
    v8i32 At[4], B0[2], B1[2];
    int sc_a = g.scale_a; asm volatile("" : "+v"(sc_a)); const int sc_b = sc_a;
    const char* cA = (const char*)g.A + (GA ? (size_t)0 : (size_t)cur.pm * tstepA) + (size_t)cur.ko; const char* cB = (const char*)g.Bt + (size_t)cur.pn * tstepB + (size_t)cur.ko;
    PG8_STAGE(PG8_SB(0, 0), cB, voffB);
    if constexpr (GA) PG8_STAGE2(PG8_SA(0, 0), cA, vgC[0][0], vgC[0][1]); else PG8_STAGE(PG8_SA(0, 0), cA, voffA);
    PG8_STAGE(PG8_SB(0, 1), cB + hstepB, voffB);
    if constexpr (GA) PG8_STAGE2(PG8_SA(0, 1), cA, vgC[1][0], vgC[1][1]); else PG8_STAGE(PG8_SA(0, 1), cA + hstepA, voffA);
    if (wr == 1) PG8_BAR;
    PG8_WAIT_V(4); PG8_BAR;
    PG8_STAGE(PG8_SB(1, 0), cB + kstep, voffB);
    if constexpr (GA) PG8_STAGE2(PG8_SA(1, 0), cA + kstep, vgC[0][0], vgC[0][1]); else PG8_STAGE(PG8_SA(1, 0), cA + kstep, voffA);
    PG8_STAGE(PG8_SB(1, 1), cB + hstepB + kstep, voffB);
    PG8_WAIT_V(6); PG8_BAR;
    for (;;) {
        const bool has_next = S.next(ui + 1, nxt);
        const char* nA = has_next ? (const char*)g.A + (GA ? (size_t)0 : (size_t)nxt.pm * tstepA) + (size_t)nxt.ko : cA; const char* nB = has_next ? (const char*)g.Bt + (size_t)nxt.pn * tstepB + (size_t)nxt.ko : cB;
        if constexpr (GA) { if (has_next) PG8_GOFFS(nxt, vgN); }
        const int ntu = cur.kt ? cur.kt : nt;
#pragma unroll 1
        for (int t = 0; t < ntu; t += 2) {
            if constexpr (Epi::HOOK_T > 0) { if (t > 0 && (t & (Epi::HOOK_T - 1)) == 0) { asm volatile("s_nop 15\n\ts_nop 15" ::: "memory"); E.mid(acc, cur, t / Epi::HOOK_T, wr, wc, fr, fq); asm volatile("s_nop 7" ::: "memory"); } }
            const bool last = (t == ntu - 2);
            const char* a1 = cA + (size_t)(t + 1) * kstep;
            const char* a2 = last ? nA : cA + (size_t)(t + 2) * kstep; const char* b2 = last ? nB : cB + (size_t)(t + 2) * kstep;
            const char* a3 = a2 + kstep; const char* b3 = b2 + kstep;
            PG8_LDB(B0, 0, 0); PG8_SCHED; PG8_LDA(At, 0, 0); if constexpr (GA) PG8_STAGE2(PG8_SA(1, 1), a1, vgC[1][0], vgC[1][1]); else PG8_STAGE(PG8_SA(1, 1), a1 + hstepA, voffA);
            PG8_WAIT_L(8); PG8_BAR; PG8_WAIT_L(0); PG8_MMA(0, 0, At, B0); PG8_BAR; PG8_SCHED;
            PG8_LDB(B1, 0, 1); PG8_STAGE(PG8_SB(0, 0), b2, voffB);
            PG8_BAR; PG8_WAIT_L(0); PG8_MMA(0, 1, At, B1); PG8_BAR;
            PG8_LDA(At, 0, 1); if constexpr (GA) PG8_STAGE2(PG8_SA(0, 0), a2, last ? vgN[0][0] : vgC[0][0], last ? vgN[0][1] : vgC[0][1]); else PG8_STAGE(PG8_SA(0, 0), a2, voffA);
            PG8_BAR; PG8_WAIT_L(0); PG8_MMA(1, 0, At, B0); PG8_BAR; PG8_SCHED;
            PG8_STAGE(PG8_SB(0, 1), b2 + hstepB, voffB);
            PG8_WAIT_V(6); PG8_BAR; PG8_MMA(1, 1, At, B1); PG8_BAR;
            PG8_LDB(B0, 1, 0); PG8_SCHED; PG8_LDA(At, 1, 0); if constexpr (GA) PG8_STAGE2(PG8_SA(0, 1), a2, last ? vgN[1][0] : vgC[1][0], last ? vgN[1][1] : vgC[1][1]); else PG8_STAGE(PG8_SA(0, 1), a2 + hstepA, voffA);
            PG8_WAIT_L(8); PG8_BAR; PG8_WAIT_L(0); PG8_MMA(0, 0, At, B0); PG8_BAR; PG8_SCHED;
            PG8_LDB(B1, 1, 1); PG8_STAGE(PG8_SB(1, 0), b3, voffB);
            PG8_BAR; PG8_WAIT_L(0); PG8_MMA(0, 1, At, B1); PG8_BAR;
            PG8_LDA(At, 1, 1); if constexpr (GA) PG8_STAGE2(PG8_SA(1, 0), a3, last ? vgN[0][0] : vgC[0][0], last ? vgN[0][1] : vgC[0][1]); else PG8_STAGE(PG8_SA(1, 0), a3, voffA);
            PG8_BAR; PG8_WAIT_L(0); PG8_MMA(1, 0, At, B0); PG8_BAR; PG8_SCHED;
            PG8_STAGE(PG8_SB(1, 1), b3 + hstepB, voffB);
            PG8_WAIT_V(6); PG8_BAR; PG8_MMA(1, 1, At, B1); PG8_BAR;
        }
        asm volatile("s_nop 15\n\ts_nop 15" ::: "memory");
        E(acc, cur, wr, wc, fr, fq);
        if (!has_next) break;
#pragma unroll
        for (int a = 0; a < 2; ++a)
#pragma unroll
            for (int b = 0; b < 2; ++b)
#pragma unroll
                for (int m = 0; m < 4; ++m)
#pragma unroll
                    for (int n = 0; n < 2; ++n) acc[a][b][m][n] = (f32x4){0.f, 0.f, 0.f, 0.f};
        cur = nxt; cA = nA; cB = nB; ++ui;
        if constexpr (GA) { vgC[0][0] = vgN[0][0]; vgC[0][1] = vgN[0][1]; vgC[1][0] = vgN[1][0]; vgC[1][1] = vgN[1][1]; }
    }
    PG8_WAIT_V(0);
    if (wr == 0) PG8_BAR;
    PG8_BAR;
#undef PG8_GOFFS
#undef PG8_STAGE2
#undef PG8_SA
#undef PG8_SB
#undef PG8_STAGE
#undef PG8_LDA
#undef PG8_LDB
#undef PG8_MMA
#undef PG8_LD32
#undef PG8_WAIT_V
#undef PG8_WAIT_L
#undef PG8_BAR
#undef PG8_SCHED
}
}
using pg8::Unit;


DI float bfly16(float (&v)[16], int lane) {
    { const bool bit = lane & 32;
#pragma unroll
      for (int j = 0; j < 8; ++j) { const float keep = bit ? v[j + 8] : v[j], send = bit ? v[j] : v[j + 8]; v[j] = keep + __shfl_xor(send, 32); } }
    { const bool bit = lane & 16;
#pragma unroll
      for (int j = 0; j < 4; ++j) { const float keep = bit ? v[j + 4] : v[j], send = bit ? v[j] : v[j + 4]; v[j] = keep + __shfl_xor(send, 16); } }
    { const bool bit = lane & 8;
#pragma unroll
      for (int j = 0; j < 2; ++j) { const float keep = bit ? v[j + 2] : v[j], send = bit ? v[j] : v[j + 2]; v[j] = keep + __shfl_xor(send, 8); } }
    { const bool bit = lane & 4; const float keep = bit ? v[1] : v[0], send = bit ? v[0] : v[1]; v[0] = keep + __shfl_xor(send, 4); }
    float r = v[0]; r += __shfl_xor(r, 2); r += __shfl_xor(r, 1); return r;
}
DI float bfly32(float (&v)[32], int lane) {
    { const bool bit = lane & 32;
#pragma unroll
      for (int j = 0; j < 16; ++j) { const float keep = bit ? v[j + 16] : v[j], send = bit ? v[j] : v[j + 16]; v[j] = keep + __shfl_xor(send, 32); } }
    { const bool bit = lane & 16;
#pragma unroll
      for (int j = 0; j < 8; ++j) { const float keep = bit ? v[j + 8] : v[j], send = bit ? v[j] : v[j + 8]; v[j] = keep + __shfl_xor(send, 16); } }
    { const bool bit = lane & 8;
#pragma unroll
      for (int j = 0; j < 4; ++j) { const float keep = bit ? v[j + 4] : v[j], send = bit ? v[j] : v[j + 4]; v[j] = keep + __shfl_xor(send, 8); } }
    { const bool bit = lane & 4;
#pragma unroll
      for (int j = 0; j < 2; ++j) { const float keep = bit ? v[j + 2] : v[j], send = bit ? v[j] : v[j + 2]; v[j] = keep + __shfl_xor(send, 4); } }
    { const bool bit = lane & 2; const float keep = bit ? v[1] : v[0], send = bit ? v[0] : v[1]; v[0] = keep + __shfl_xor(send, 2); }
    float r = v[0]; r += __shfl_xor(r, 1); return r;
}
DI f32x4 ld4(const float* p) { return *(const f32x4*)p; }
DI f32x4 bf4(u32x2 w) { return (f32x4){bflo(w.x), bfhi(w.x), bflo(w.y), bfhi(w.y)}; }

DI void tr8_load(const int tid, const float* src, size_t ld_src, f32x4 (&v)[4]) {
#pragma unroll
    for (int it = 0; it < 4; ++it) { const int k = 4 * (tid >> 5) + it, n4 = (tid & 31) * 4; v[it] = ld4(src + (size_t)k * ld_src + n4); }
}
DI void tr8_finish(const int tid, const f32x4 (&v)[4], unsigned char* dst, size_t ld_dst, LAS float* Tl) {
    LAS unsigned* Tw = (LAS unsigned*)Tl;
    __syncthreads();
    { const int kq = tid >> 5, nq = tid & 31;
#pragma unroll
      for (int j = 0; j < 4; ++j) Tw[(4 * nq + j) * 17 + kq] = pk_fp8x4(v[0][j] * 64.f, v[1][j] * 64.f, v[2][j] * 64.f, v[3][j] * 64.f); }
    __syncthreads();
    { const int n = tid >> 2, kq = tid & 3; const LAS unsigned* rp = Tw + n * 17 + 4 * kq;
      u32x4 w; w.x = rp[0]; w.y = rp[1]; w.z = rp[2]; w.w = rp[3];
      *(u32x4*)(dst + (size_t)n * ld_dst + kq * 16) = w; }
}
DI void tr_tile8(const int tid, const float* src, size_t ld_src, unsigned char* dst, size_t ld_dst, LAS float* Tl) {
    f32x4 v[4]; tr8_load(tid, src, ld_src, v); tr8_finish(tid, v, dst, ld_dst, Tl);
}
DI void tr16_finish(const int tid, const f32x4 (&v)[4], bf16_t* dst, size_t ld_dst, LAS float* Tl) {
    __syncthreads();
#pragma unroll
    for (int it = 0; it < 4; ++it) { const int k = 4 * (tid >> 5) + it, n4 = (tid & 31) * 4;
        Tl[k * 129 + n4] = v[it][0]; Tl[k * 129 + n4 + 1] = v[it][1]; Tl[k * 129 + n4 + 2] = v[it][2]; Tl[k * 129 + n4 + 3] = v[it][3]; }
    __syncthreads();
#pragma unroll
    for (int it = 0; it < 2; ++it) {
        const int n = (tid >> 3) + 64 * it, kq = tid & 7;
        float a[8];
#pragma unroll
        for (int j = 0; j < 8; ++j) a[j] = Tl[(kq * 8 + j) * 129 + n];
        u32x4 w; w.x = pk2(a[0], a[1]); w.y = pk2(a[2], a[3]); w.z = pk2(a[4], a[5]); w.w = pk2(a[6], a[7]);
        *(u32x4*)(dst + (size_t)n * ld_dst + kq * 8) = w;
    }
}

DI bool dense_tile(const Ctx& X, int t, const float*& src, size_t& ld_src, unsigned char*& dst, size_t& ld_dst) {
    if (t < 2304) { const int l = t / 1152, r = t % 1152, kt = r / 72, nt = r % 72, n0 = nt * 128;
        src = X.kp->in[I_WIN] + ((size_t)l * 1024 + kt * 64) * WIN_LD + n0 + (n0 >= 2048 ? 16 : 0); ld_src = WIN_LD;
        dst = X.ws + OFF_win8 + ((size_t)l * NPROJ + n0) * 1024 + kt * 64; ld_dst = 1024; return false; }
    if (t < 2816) { int r = t - 2304; const int l = r / 256; r %= 256; const int i = r / 64; r %= 64; const int kt = r / 8, nt = r % 8;
        src = X.kp->in[I_WBR] + ((size_t)(l * 4 + i) * 512 + kt * 64) * 1024 + nt * 128; ld_src = 1024;
        dst = X.ws + OFF_wbr + ((size_t)l * 1024 + nt * 128) * 2048 + i * 512 + kt * 64; ld_dst = 2048; return false; }
    int r = t - 2816; const int l = r / 128; r %= 128; const int kt = r / 8, nt = r % 8;
    src = X.kp->in[I_WOUT] + ((size_t)l * 1024 + kt * 64) * 1024 + nt * 128; ld_src = 1024;
    dst = X.ws + OFF_wout + ((size_t)l * 1024 + nt * 128) * 1024 + kt * 64; ld_dst = 1024; return false;
}
DI void convert_dense(const Ctx& X, int t_begin, int t_end) {
    LAS float* Tl = (LAS float*)X.lds;
    const float* src; size_t ld_src; unsigned char* dst; size_t ld_dst;
    f32x4 v[4], vn[4], vm[4];
    unsigned char* d0; size_t l0; unsigned char* d1 = nullptr; size_t l1 = 0; bool b0, b1 = false;
    b0 = dense_tile(X, t_begin, src, ld_src, d0, l0); tr8_load(X.tid, src, ld_src, v);
    if (t_begin + 1 < t_end) { b1 = dense_tile(X, t_begin + 1, src, ld_src, d1, l1); tr8_load(X.tid, src, ld_src, vn); }
    for (int t = t_begin; t < t_end; ++t) {
        unsigned char* d2 = nullptr; size_t l2 = 0; bool b2 = false;
        if (t + 2 < t_end) { b2 = dense_tile(X, t + 2, src, ld_src, d2, l2); tr8_load(X.tid, src, ld_src, vm); }
        if (b0) tr16_finish(X.tid, v, (bf16_t*)d0, l0, Tl); else tr8_finish(X.tid, v, d0, l0, Tl);
#pragma unroll
        for (int i = 0; i < 4; ++i) { v[i] = vn[i]; vn[i] = vm[i]; }
        d0 = d1; l0 = l1; b0 = b1; d1 = d2; l1 = l2; b1 = b2;
    }
    __syncthreads();
}
DI void phase_pro(const Ctx& X) {
    const int tid = X.tid, lane = X.lane, wv = X.wv;
    LAS float* sc = (LAS float*)X.lds;
    LAS float* red = (LAS float*)(X.lds + 36864);
    for (int i = tid; i < 9 * 1024; i += NTHR) { const float v = (i < 8192) ? X.kp->in[I_C][i] : X.kp->in[I_CCTX][i - 8192]; sc[i] = v / (1.f + expf(-v)); }
    __syncthreads();
    float* modv = (float*)(X.ws + OFF_modv);
    for (int w = X.bid; w < 192; w += X.G) {
        const int l = w / 96, cb = w % 96, col = cb * 64 + lane;
        float acc[9];
#pragma unroll
        for (int r = 0; r < 9; ++r) acc[r] = 0.f;
        const float* wm = X.kp->in[I_WMOD] + (size_t)l * 1024 * 6144 + col;
        for (int k = wv * 128; k < wv * 128 + 128; ++k) { const float wk = wm[(size_t)k * 6144];
#pragma unroll
            for (int r = 0; r < 9; ++r) acc[r] += sc[r * 1024 + k] * wk; }
#pragma unroll
        for (int r = 0; r < 9; ++r) red[(wv * 9 + r) * 64 + lane] = acc[r];
        __syncthreads();
        for (int o = tid; o < 576; o += NTHR) { const int r = o >> 6, cc = o & 63; float s = X.kp->in[I_BMOD][l * 6144 + cb * 64 + cc];
#pragma unroll
            for (int q = 0; q < 8; ++q) s += red[(q * 9 + r) * 64 + cc];
            modv[(size_t)(l * 9 + r) * 6144 + cb * 64 + cc] = s; }
        __syncthreads();
    }
    if (X.bid == X.G - 1) {
        float* rope = (float*)(X.ws + OFF_rope);
        for (int i = tid; i < 1024; i += NTHR) { const int p = i >> 4, j = i & 15; const float invf = powf(10000.f, -(float)j / 16.f), ang = (float)p * invf; rope[2 * i] = cosf(ang); rope[2 * i + 1] = sinf(ang); }
    }
    __syncthreads();
    convert_dense(X, (X.bid * 1152) / X.G, ((X.bid + 1) * 1152) / X.G);
}
DI void expert_tile(const Ctx& X, int l, int t, const float*& src, size_t& ld_src, unsigned char*& dst, size_t& ld_dst) {
    if (t < 4096) { const int which = t / 2048; int r = t % 2048; const int e = r / 64; r %= 64; const int kt = r / 4, nt = r % 4;
        src = X.kp->in[which ? I_EU : I_EG] + ((size_t)(l * NE + e) * 1024 + kt * 64) * 512 + nt * 128; ld_src = 512;
        dst = X.ws + OFF_wgu + ((size_t)e * 1024 + nt * 256 + which * 128) * 1024 + kt * 64; ld_dst = 1024; }
    else { int r = t - 4096; const int e = r / 64; r %= 64; const int kt = r / 8, nt = r % 8;
        src = X.kp->in[I_ED] + ((size_t)(l * NE + e) * 512 + kt * 64) * 1024 + nt * 128; ld_src = 1024;
        dst = X.ws + OFF_wdn + ((size_t)e * 1024 + nt * 128) * 512 + kt * 64; ld_dst = 512; }
}
DI void convert_experts(const Ctx& X, int l, int t_begin, int t_end) {
    LAS float* Tl = (LAS float*)X.lds;
    const float* src; size_t ld_src; unsigned char* dst; size_t ld_dst;
    f32x4 v[4], vn[4], vm[4];
    unsigned char* d0; size_t l0; unsigned char* d1 = nullptr; size_t l1 = 0;
    expert_tile(X, l, t_begin, src, ld_src, d0, l0); tr8_load(X.tid, src, ld_src, v);
    if (t_begin + 1 < t_end) { expert_tile(X, l, t_begin + 1, src, ld_src, d1, l1); tr8_load(X.tid, src, ld_src, vn); }
    for (int t = t_begin; t < t_end; ++t) {
        unsigned char* d2 = nullptr; size_t l2 = 0;
        if (t + 2 < t_end) { expert_tile(X, l, t + 2, src, ld_src, d2, l2); tr8_load(X.tid, src, ld_src, vm); }
        tr8_finish(X.tid, v, d0, l0, Tl);
#pragma unroll
        for (int i = 0; i < 4; ++i) { v[i] = vn[i]; vn[i] = vm[i]; }
        d0 = d1; l0 = l1; d1 = d2; l1 = l2;
    }
    __syncthreads();
}

DI void moe_combine(const Ctx& X, int lp, int row, int b, bool isctx, f32x4 (&xv)[4]) {
    const int* tokS = (const int*)(X.ws + OFF_tokS); const float* tokW = (const float*)(X.ws + OFF_tokW);
    const unsigned char* ys = X.ws + OFF_ys;
    const float* ga2 = (const float*)(X.ws + OFF_modv) + (size_t)(lp * 9 + (isctx ? 8 : b)) * 6144 + 5120;
    const int s0 = tokS[row * 2], s1 = tokS[row * 2 + 1]; const float w0 = tokW[row * 2] * 0.0625f, w1 = tokW[row * 2 + 1] * 0.0625f;
#pragma unroll
    for (int i = 0; i < 4; ++i) { const int d = X.lane * 4 + 256 * i;
        const int q0 = *(const int*)(ys + (size_t)s0 * 1024 + d), q1 = *(const int*)(ys + (size_t)s1 * 1024 + d);
        const f32x2 a0 = __builtin_amdgcn_cvt_pk_f32_fp8(q0, false), a1 = __builtin_amdgcn_cvt_pk_f32_fp8(q0, true), c0 = __builtin_amdgcn_cvt_pk_f32_fp8(q1, false), c1 = __builtin_amdgcn_cvt_pk_f32_fp8(q1, true);
        const f32x4 y0 = {a0.x, a0.y, a1.x, a1.y}, y1 = {c0.x, c0.y, c1.x, c1.y};
        xv[i] += ld4(ga2 + d) * (y0 * w0 + y1 * w1); }
}

DI void phase_pre(const Ctx& X, int l) {
    const int tid = X.tid, lane = X.lane;
    LAS float* wT = (LAS float*)X.lds;
    { const float* win = X.kp->in[I_WIN] + (size_t)l * D * WIN_LD;
      for (int i = tid; i < 16 * 1024; i += NTHR) { const int d = i >> 4, j = i & 15; wT[j * 1024 + d] = win[(size_t)d * WIN_LD + 2048 + j]; } }
    __syncthreads();
    const float* g1 = X.kp->in[I_N1G] + l * D; const float* gateb = X.kp->in[I_GATEB] + l * 16;
    const float* modv = (const float*)(X.ws + OFF_modv);
    float* xc = (float*)(X.ws + OFF_xc);
    float* gI = (float*)(X.ws + OFF_gI); float* gF = (float*)(X.ws + OFF_gF);
    f32x4 nx[4];
#define PRE_SRC(rw) ({ const int b_ = (rw) / TPB, tt_ = (rw) % TPB; const bool c_ = tt_ < CTX; const size_t o_ = c_ ? ((size_t)b_ * CTX + tt_) * D : ((size_t)b_ * SEQ + (tt_ - CTX)) * D; \
        (l == 0) ? (c_ ? X.kp->in[I_CTX] + o_ : X.kp->in[I_X] + o_) : (c_ ? (const float*)xc + o_ : (const float*)X.out + o_); })
    { const int row0 = X.bid * 8 + X.wv; if (row0 < T) { const float* s0 = PRE_SRC(row0);
#pragma unroll
        for (int i = 0; i < 4; ++i) nx[i] = ld4(s0 + lane * 4 + 256 * i); } }
    for (int row = X.bid * 8 + X.wv; row < T; row += X.G * 8) {
        const int b = row / TPB, tt = row % TPB; const bool isctx = tt < CTX;
        const float* modr = modv + (size_t)(l * 9 + (isctx ? 8 : b)) * 6144;
        float* xrw = isctx ? xc + ((size_t)b * CTX + tt) * D : X.out + ((size_t)b * SEQ + (tt - CTX)) * D;
        f32x4 xv[4];
#pragma unroll
        for (int i = 0; i < 4; ++i) xv[i] = nx[i];
        { const int nrow = row + X.G * 8; if (nrow < T) { const float* s1 = PRE_SRC(nrow);
#pragma unroll
            for (int i = 0; i < 4; ++i) nx[i] = ld4(s1 + lane * 4 + 256 * i); } }
        if (l > 0) { moe_combine(X, l - 1, row, b, isctx, xv);
#pragma unroll
            for (int i = 0; i < 4; ++i) *(f32x4*)(xrw + lane * 4 + 256 * i) = xv[i]; }
        float ss = 0.f;
#pragma unroll
        for (int i = 0; i < 4; ++i) ss += xv[i][0] * xv[i][0] + xv[i][1] * xv[i][1] + xv[i][2] * xv[i][2] + xv[i][3] * xv[i][3];
        ss = wave_sum(ss); const float rr = rsqrtf(ss * (1.f / 1024.f) + EPS);
        f32x4 hv[4];
#pragma unroll
        for (int i = 0; i < 4; ++i) { const int d = lane * 4 + 256 * i;
            hv[i] = xv[i] * rr * ld4(g1 + d) * (ld4(modr + 1024 + d) + 1.f) + ld4(modr + d);
            *(unsigned*)(X.ws + OFF_h8in + (size_t)row * D + d) = pk_fp8x4(hv[i][0], hv[i][1], hv[i][2], hv[i][3]); }
        float ga[16];
#pragma unroll
        for (int j = 0; j < 16; ++j) { f32x2 pp = {0.f, 0.f};
#pragma unroll
            for (int i = 0; i < 4; ++i) { const f32x4 w = *(const LAS f32x4*)(wT + j * 1024 + lane * 4 + 256 * i);
                pp += (f32x2){hv[i][0], hv[i][1]} * (f32x2){w[0], w[1]}; pp += (f32x2){hv[i][2], hv[i][3]} * (f32x2){w[2], w[3]}; }
            ga[j] = pp.x + pp.y; if ((j & 3) == 3) __builtin_amdgcn_sched_barrier(0); }
        const float gsum = bfly16(ga, lane);
        if ((lane & 3) == 0) { const int j = lane >> 2;
            const float g = gsum + gateb[j]; const int dir = j >> 3, ty = (j >> 2) & 1, hd = j & 3;
            const size_t gi = ((size_t)(dir * NB + b) * 4 + hd) * TPB + tt;
            if (ty == 0) gI[gi] = g; else gF[gi] = fminf(g, 0.f) - __logf(1.f + __expf(-fabsf(g))); }
    }
    __syncthreads();
}

DI void phase_elt(const Ctx& X, int l) {
    const int tid = X.tid, lane = X.lane;
    LAS float* ropeL = (LAS float*)X.lds;
    { const float* rope = (const float*)(X.ws + OFF_rope); for (int i = tid; i < 2048; i += NTHR) ropeL[i] = rope[i]; }
    __syncthreads();
    bf16_t* PA = (bf16_t*)(X.ws + uo_projA(X.rs));
    const int pi = lane & 31, hsel = lane >> 5, fj = pi & 15;
    const float gk0 = X.kp->in[I_KNORM][l * 64 + 2 * pi], gk1 = X.kp->in[I_KNORM][l * 64 + 2 * pi + 1];
    for (int row = X.bid * 8 + X.wv; row < X.rs; row += X.G * 8) {
        const int tt = row % TPB; const bool isctx = tt < CTX; const int t = tt - CTX;
        const int pos = (pi < 16) ? (t >> 6) : (t & 63);
        float cs = 1.f, sn = 0.f; if (!isctx) { cs = ropeL[(pos * 16 + fj) * 2]; sn = ropeL[(pos * 16 + fj) * 2 + 1]; }
        bf16_t* pr = PA + (size_t)row * NPA;
        unsigned xin[2];
#pragma unroll
        for (int st = 0; st < 2; ++st) xin[st] = *(const unsigned*)(pr + (st == 0 ? C_GK : C_WK) + 64 * hsel + 2 * pi);
        asm volatile("" ::: "memory");
#pragma unroll
        for (int st = 0; st < 2; ++st) {
            float x0 = bflo(xin[st]), x1 = bfhi(xin[st]);
            if (st == 0) { float ss = x0 * x0 + x1 * x1;
#pragma unroll
                for (int o = 16; o >= 1; o >>= 1) ss += __shfl_xor(ss, o);
                const float rr = rsqrtf(ss * (1.f / 64.f) + EPS); x0 = x0 * rr * gk0; x1 = x1 * rr * gk1; }
            { const float y0 = x0 * cs - x1 * sn, y1 = x0 * sn + x1 * cs; x0 = y0; x1 = y1; }
            *(unsigned*)(pr + (st == 0 ? C_GK : C_WK) + 64 * hsel + 2 * pi) = pk2(x0, x1);
        }
    }
    { const bf16_t* HALO = (const bf16_t*)(X.ws + OFF_halo); const float* cwg = X.kp->in[I_CONVW] + (size_t)l * 3 * 1024; const float* cbg = X.kp->in[I_CONVB] + l * 1024;
      const int ntask = (X.rs / 68) * 8;
      for (int task = X.bid * 8 + X.wv; task < ntask; task += X.G * 8) {
        const int rg = task >> 3, c = (task & 7) * 128 + lane * 2, r0 = rg * 68, t0 = r0 % TPB;
        const float w00 = cwg[c], w01 = cwg[c + 1], w10 = cwg[1024 + c], w11 = cwg[1024 + c + 1], w20 = cwg[2048 + c], w21 = cwg[2048 + c + 1], b0 = cbg[c], b1 = cbg[c + 1];
        const float sc = c >= 512 ? 0.08838834764831845f : 1.f;
        bf16_t* base = PA + (size_t)r0 * NPA + c;
        unsigned xprev = (t0 == 0) ? 0u : *(const unsigned*)(HALO + ((size_t)(rg - 1) * 2 + 1) * 1024 + c);
        const unsigned xlast = (t0 + 68 == TPB) ? 0u : *(const unsigned*)(HALO + ((size_t)(rg + 1) * 2) * 1024 + c);
        unsigned xcur = *(const unsigned*)base;
#pragma unroll
        for (int hb = 0; hb < 2; ++hb) {
            unsigned xr[36]; xr[0] = xprev; xr[1] = xcur;
#pragma unroll
            for (int i = 1; i < 34; ++i) xr[i + 1] = *(const unsigned*)(base + (size_t)(hb * 34 + i) * NPA);
            xr[35] = hb ? xlast : *(const unsigned*)(base + (size_t)34 * NPA);
            asm volatile("" ::: "memory");
#pragma unroll
            for (int i = 0; i < 34; ++i) {
                const int tb = t0 + hb * 34 + i; const bool ss = (tb == 0 || tb == CTX), se = (tb == CTX - 1 || tb == TPB - 1);
                const unsigned xp = ss ? 0u : xr[i], xn = se ? 0u : xr[i + 2];
                const float a0 = w00 * bflo(xp) + w10 * bflo(xr[i + 1]) + w20 * bflo(xn) + b0, a1 = w01 * bfhi(xp) + w11 * bfhi(xr[i + 1]) + w21 * bfhi(xn) + b1;
                *(unsigned*)(base + (size_t)(hb * 34 + i) * NPA) = pk2(siluf_(a0) * sc, siluf_(a1) * sc);
            }
            xprev = xr[34]; xcur = xr[35];
        }
      }
    }
    __syncthreads();
}

DI void phase_cmb(const Ctx& X, int l) {
    const int lane = X.lane;
    const bf16_t* PA = (const bf16_t*)(X.ws + uo_projA(X.rs)); const bf16_t* hp = (const bf16_t*)(X.ws + uo_hpart(X.rs)); bf16_t* bc = (bf16_t*)(X.ws + uo_bcat(X.rs));
    const float* ng = X.kp->in[I_MNORMG] + l * 512;
    for (int row = X.bid * 8 + X.wv; row < X.rs; row += X.G * 8) {
        unsigned hf[4], hb[4], o[4];
#pragma unroll
        for (int hd = 0; hd < 4; ++hd) { const int c = hd * 128 + lane * 2;
            hf[hd] = *(const unsigned*)(hp + (size_t)row * 512 + c); hb[hd] = *(const unsigned*)(hp + ((size_t)X.rs + row) * 512 + c); o[hd] = *(const unsigned*)(PA + (size_t)row * NPA + C_MO + c); }
#pragma unroll
        for (int hd = 0; hd < 4; ++hd) { const int c = hd * 128 + lane * 2;
            const float v0 = bflo(hf[hd]) + bflo(hb[hd]), v1 = bfhi(hf[hd]) + bfhi(hb[hd]);
            const float ss = wave_sum(v0 * v0 + v1 * v1), rr = rsqrtf(ss * (1.f / 128.f) + EPS);
            *(unsigned short*)((unsigned char*)bc + (size_t)row * 2048 + c) = (unsigned short)pk_fp8x4(v0 * rr * ng[c] * sigmoidf_(bflo(o[hd])), v1 * rr * ng[c + 1] * sigmoidf_(bfhi(o[hd])), 0.f, 0.f); }
    }
}

DI void phase_rte(const Ctx& X, int l) {
    const int tid = X.tid, lane = X.lane;
    LAS float* wrT = (LAS float*)X.lds;
    for (int i = tid; i < 32 * 1024; i += NTHR) { const int d = i >> 5, e = i & 31; wrT[e * 1024 + d] = X.kp->in[I_WR][i]; }
    __syncthreads();
    const float* g2 = X.kp->in[I_N2G] + l * D; const float* modv = (const float*)(X.ws + OFF_modv);
    const float* xc = (const float*)(X.ws + OFF_xc); unsigned char* H8 = X.ws + OFF_h8;
    int* tokE = (int*)(X.ws + OFF_tokE); int* tokS = (int*)(X.ws + OFF_tokS); float* tokW = (float*)(X.ws + OFF_tokW);
    unsigned* cnt = X.ctl + CW_CNT + l * 32 * 64;
    LAS unsigned* lcnt = (LAS unsigned*)(X.lds + MISC_OFF + 3072);
    if (tid < 64) lcnt[tid] = 0u;
    __syncthreads();
    const float rbias = X.kp->in[I_RB][lane & 31];
    const int nidx = l > 0 ? NB * SEQ : T;
    LAS float* lg2 = (LAS float*)(X.lds + MISC_OFF + 8192) + X.wv * 64;
    f32x4 nx[2][4];
#define RTE_ROW(ix) (l > 0 ? ((ix) / SEQ) * TPB + CTX + (ix) % SEQ : (ix))
#define RTE_SRC(rw) ({ const int b_ = (rw) / TPB, tt_ = (rw) % TPB; (tt_ < CTX) ? xc + ((size_t)b_ * CTX + tt_) * D : (const float*)X.out + ((size_t)b_ * SEQ + (tt_ - CTX)) * D; })
    const int stride = X.G * 8, idx0 = X.bid * 8 + X.wv;
#define RTE_FETCH(ixa) do { _Pragma("unroll") for (int t_ = 0; t_ < 2; ++t_) { int ix_ = (ixa) + t_ * stride; if (ix_ >= nidx) ix_ = (ixa); if (ix_ < nidx) { const float* s_ = RTE_SRC(RTE_ROW(ix_)); \
        _Pragma("unroll") for (int i = 0; i < 4; ++i) nx[t_][i] = ld4(s_ + lane * 4 + 256 * i); } } } while (0)
    RTE_FETCH(idx0);
    for (int idx = idx0; idx < nidx; idx += 2 * stride) {
        const bool has2 = idx + stride < nidx;
        int rows[2]; rows[0] = RTE_ROW(idx); rows[1] = has2 ? RTE_ROW(idx + stride) : rows[0];
        f32x4 hv[2][4];
        {
            f32x4 xv[2][4]; float ss[2] = {0.f, 0.f};
#pragma unroll
            for (int t = 0; t < 2; ++t)
#pragma unroll
                for (int i = 0; i < 4; ++i) { xv[t][i] = nx[t][i]; ss[t] += xv[t][i][0] * xv[t][i][0] + xv[t][i][1] * xv[t][i][1] + xv[t][i][2] * xv[t][i][2] + xv[t][i][3] * xv[t][i][3]; }
            if (idx + 2 * stride < nidx) RTE_FETCH(idx + 2 * stride);
#pragma unroll
            for (int t = 0; t < 2; ++t) {
                const int row = rows[t], b = row / TPB, tt = row % TPB; const bool isctx = tt < CTX;
                const float* modr = modv + (size_t)(l * 9 + (isctx ? 8 : b)) * 6144;
                const float rr = rsqrtf(wave_sum(ss[t]) * (1.f / 1024.f) + EPS);
#pragma unroll
                for (int i = 0; i < 4; ++i) { const int d = lane * 4 + 256 * i;
                    hv[t][i] = xv[t][i] * rr * ld4(g2 + d) * (ld4(modr + 4096 + d) + 1.f) + ld4(modr + 3072 + d);
                    if (t == 0 || has2) *(unsigned*)(H8 + (size_t)row * D + d) = pk_fp8x4(hv[t][i][0], hv[t][i][1], hv[t][i][2], hv[t][i][3]); }
            }
        }
        {
            float a0[32], a1[32];
#pragma unroll
            for (int e = 0; e < 32; ++e) { f32x2 p0 = {0.f, 0.f}, p1 = {0.f, 0.f};
#pragma unroll
                for (int i = 0; i < 4; ++i) { const f32x4 w = *(const LAS f32x4*)(wrT + e * 1024 + lane * 4 + 256 * i);
                    const f32x2 wl = {w[0], w[1]}, wh = {w[2], w[3]};
                    p0 += (f32x2){hv[0][i][0], hv[0][i][1]} * wl; p0 += (f32x2){hv[0][i][2], hv[0][i][3]} * wh;
                    p1 += (f32x2){hv[1][i][0], hv[1][i][1]} * wl; p1 += (f32x2){hv[1][i][2], hv[1][i][3]} * wh; }
                a0[e] = p0.x + p0.y; a1[e] = p1.x + p1.y; }
            const float l0 = bfly32(a0, lane), l1 = bfly32(a1, lane);
            if ((lane & 1) == 0) { lg2[lane >> 1] = l0; lg2[32 + (lane >> 1)] = l1; }
            asm volatile("s_waitcnt lgkmcnt(0)" ::: "memory");
        }
#pragma unroll 1
        for (int t = 0; t < 2; ++t) {
            if (t == 1 && !has2) break;
            const int row = rows[t];
            const float logit = lg2[t * 32 + (lane & 31)];
            const float score = 1.f / (1.f + expf(-logit)), sel = score + rbias;
            float m1 = sel; m1 = fmaxf(m1, __shfl_xor(m1, 1)); m1 = fmaxf(m1, __shfl_xor(m1, 2)); m1 = fmaxf(m1, __shfl_xor(m1, 4));
            const unsigned long long segm = 0xFFull << (lane & 56);
            const int i1 = __ffsll((long long)(__ballot(sel == m1) & segm)) - 1;
            const float v2 = (lane == i1) ? -3.0e38f : sel;
            float m2 = v2; m2 = fmaxf(m2, __shfl_xor(m2, 1)); m2 = fmaxf(m2, __shfl_xor(m2, 2)); m2 = fmaxf(m2, __shfl_xor(m2, 4));
            const int i2 = __ffsll((long long)(__ballot(v2 == m2) & segm)) - 1;
            const float gs = m1 + m2;
            const float gs0 = __shfl(gs, 0), gs1 = __shfl(gs, 8), gs2 = __shfl(gs, 16), gs3 = __shfl(gs, 24);
            int grp = 0; float gb = gs0; if (gs1 > gb) { gb = gs1; grp = 1; } if (gs2 > gb) { gb = gs2; grp = 2; } if (gs3 > gb) { gb = gs3; grp = 3; }
            const int e1 = __shfl(i1, grp * 8), e2 = __shfl(i2, grp * 8);
            const float w1 = __shfl(score, e1), w2 = __shfl(score, e2), wn = 1.f / (w1 + w2);
            if (lane == 0) {
                const unsigned p1 = __hip_atomic_fetch_add(lcnt + e1, 1u, __ATOMIC_RELAXED, __HIP_MEMORY_SCOPE_WORKGROUP), p2 = __hip_atomic_fetch_add(lcnt + e2, 1u, __ATOMIC_RELAXED, __HIP_MEMORY_SCOPE_WORKGROUP);
                tokE[row * 2] = e1; tokE[row * 2 + 1] = e2; tokS[row * 2] = (int)p1; tokS[row * 2 + 1] = (int)p2; tokW[row * 2] = w1 * wn; tokW[row * 2 + 1] = w2 * wn;
            }
        }
    }
#undef RTE_FETCH
    __syncthreads();
    if (tid < 32) lcnt[32 + tid] = lcnt[tid] ? atomicAdd(cnt + tid * 64, lcnt[tid]) : 0u;
    __syncthreads();
    for (int idx = X.bid * 8 + X.wv; idx < nidx; idx += X.G * 8) {
        const int row = RTE_ROW(idx);
        if (lane < 2) tokS[row * 2 + lane] += (int)lcnt[32 + tokE[row * 2 + lane]];
    }
    __syncthreads();
}

DI void build_expert_tables(const Ctx& X, int l) {
    LAS int* baseE = (LAS int*)(X.lds + MISC_OFF + 4096); LAS int* tileE = (LAS int*)(X.lds + MISC_OFF + 4352);
    __syncthreads();
    if (X.wv == 0) {
        const int c = (X.lane < 32) ? (int)X.ctl[CW_CNT + (l * 32 + X.lane) * 64] : 0, pad = (c + 255) & ~255;
        int inc = pad;
#pragma unroll
        for (int o = 1; o < 32; o <<= 1) { const int t = __shfl_up(inc, o); if (X.lane >= o) inc += t; }
        if (X.lane < 32) { baseE[X.lane] = inc - pad; ((LAS int*)(X.lds + MISC_OFF + 6144))[X.lane] = c; }
        if (X.lane == 31) { baseE[32] = inc; baseE[33] = inc >> 8; }
    }
    __syncthreads();
    if (X.tid < 320) { const int r0 = X.tid * 256; int e = 0;
#pragma unroll
        for (int k = 1; k < 32; ++k) e += (baseE[k] <= r0) ? 1 : 0;
        tileE[X.tid] = e; }
    __syncthreads();
}
DI void phase_gat(const Ctx& X, int l) {
    build_expert_tables(X, l);
    const LAS int* baseE = (const LAS int*)(X.lds + MISC_OFF + 4096); const LAS int* cntE = (const LAS int*)(X.lds + MISC_OFF + 6144);
    const int* tokE = (const int*)(X.ws + OFF_tokE); int* tokS = (int*)(X.ws + OFF_tokS); int* slotTok = (int*)(X.ws + OFF_xs);
    for (int pr = X.bid * NTHR + X.tid; pr < T * 2; pr += X.G * NTHR) {
        const int row = pr >> 1;
        if (l > 0 && (row % TPB) < CTX) continue;
        const int slot = baseE[tokE[pr]] + tokS[pr];
        tokS[pr] = slot; slotTok[slot] = row;
    }
    if (X.bid < 32) { const int e = X.bid, b0 = baseE[e] + cntE[e], b1 = baseE[e + 1]; for (int sl = b0 + X.tid; sl < b1; sl += NTHR) slotTok[sl] = (l > 0) ? CTX : 0; }
    __syncthreads();
}
DI void phase_fin(const Ctx& X) {
    const int lane = X.lane; const float* fg = X.kp->in[I_FING];
    for (int r = X.bid * 8 + X.wv; r < NB * SEQ; r += X.G * 8) {
        const int b = r / SEQ, t = r % SEQ, row = b * TPB + CTX + t;
        float* xr = X.out + (size_t)r * D; f32x4 xv[4];
#pragma unroll
        for (int i = 0; i < 4; ++i) xv[i] = ld4(xr + lane * 4 + 256 * i);
        moe_combine(X, 1, row, b, false, xv);
        float ss = 0.f;
#pragma unroll
        for (int i = 0; i < 4; ++i) ss += xv[i][0] * xv[i][0] + xv[i][1] * xv[i][1] + xv[i][2] * xv[i][2] + xv[i][3] * xv[i][3];
        ss = wave_sum(ss); const float rr = rsqrtf(ss * (1.f / 1024.f) + EPS);
#pragma unroll
        for (int i = 0; i < 4; ++i) *(f32x4*)(xr + lane * 4 + 256 * i) = xv[i] * rr * ld4(fg + lane * 4 + 256 * i);
    }
}

struct TileSched {
    static constexpr bool GATHER = false; DI int row_of(int r) const { return r; }
    int nM, nN, G, c, lat;
    DI bool next(int i, Unit& u) const { const int L = i * G + c; if (L >= nM * nN) return false; int j, pn; pg8::tile_order(L, nM, nN, j, pn);
        u.pm = lat ? (j >> 4) * 17 + 1 + (j & 15) : j; u.pn = pn; u.ko = 0; u.aux = 0; u.kt = 0; return true; }
};
struct MrgSched0 { static constexpr bool GATHER = false; DI int row_of(int r) const { return r; } int nb, G, c;
    DI bool next(int i, Unit& u) const { int L = i * G + c; const int nfull = nb * 64;
        if (L < nfull) { int j, pn; pg8::tile_order(L, nb * 16, 4, j, pn); u.pm = (j >> 4) * 17 + 1 + (j & 15); u.pn = pn; u.ko = 0; u.aux = 0; u.kt = 0; return true; }
        L -= nfull; if (L >= nb * 16) return false;
        const int c4 = L >> 2, br = L & 3; u.pm = (c4 >> 2) * 17; u.pn = c4 & 3; u.ko = br * 512; u.aux = 8 + br + (c4 << 4); u.kt = 4; return true; }
};
struct ExpSched { static constexpr bool GATHER = false; DI int row_of(int r) const { return r; } const LAS int* tileE; int ntiles, G, c;
    DI bool next(int i, Unit& u) const { const int L = i * G + c, rt = L >> 2; if (rt >= ntiles) return false; const int pnl = L & 3; u.pm = rt; u.pn = __builtin_amdgcn_readfirstlane(tileE[rt]) * 4 + pnl; u.ko = 0; u.aux = pnl; u.kt = 0; return true; }
};
struct ExpSchedG { static constexpr bool GATHER = true; const int* rowmap; DI int row_of(int r) const { return rowmap[r]; } const LAS int* tileE; int ntiles, G, c;
    DI bool next(int i, Unit& u) const { const int L = i * G + c, rt = L >> 2; if (rt >= ntiles) return false; const int pnl = L & 3; u.pm = rt; u.pn = __builtin_amdgcn_readfirstlane(tileE[rt]) * 4 + pnl; u.ko = 0; u.aux = pnl; u.kt = 0; return true; }
};
typedef f32x4 AccT[2][2][4][2];
struct EpiProj { static constexpr int HOOK_T = 0; static constexpr bool PERM = true; bf16_t* PA; bf16_t* PG; bf16_t* HALO;
    DI void operator()(const AccT& acc, const Unit& u, int wr, int wc, int fr, int fq) const {
        const int colt = u.pn * 256; bf16_t* base; int ld; if (colt < NPA) { base = PA + colt; ld = NPA; } else { base = PG + (colt - NPA); ld = NPG; }
#pragma unroll
        for (int ai = 0; ai < 2; ++ai)
#pragma unroll
            for (int m = 0; m < 4; ++m) { const int row = u.pm * 256 + ai * 128 + wr * 64 + m * 16 + fr; bf16_t* rp = base + (size_t)row * ld + wc * 32 + 8 * fq;
#pragma unroll
                for (int bj = 0; bj < 2; ++bj) { f32x4 v0 = acc[ai][bj][m][0], v1 = acc[ai][bj][m][1];
                    if (colt >= NPA) {
#pragma unroll
                        for (int q = 0; q < 4; ++q) { v0[q] = 1.f + __expf(-fminf(fmaxf(v0[q], -10.f), 10.f)); v1[q] = 1.f + __expf(-fminf(fmaxf(v1[q], -10.f), 10.f)); } }
                    u32x4 w; w.x = pk2(v0[0], v0[1]); w.y = pk2(v0[2], v0[3]); w.z = pk2(v1[0], v1[1]); w.w = pk2(v1[2], v1[3]);
                    if (colt >= NPA) {
                        bf16_t* gq = PG + ((size_t)u.pm * 16 + (u.pn - NPA / 256)) * 65536 + (((ai * 4 + m) * 2 + bj) * 8 + wr * 4 + wc) * 512 + (fr + 32 * (fq & 1)) * 8 + (fq >> 1) * 4;
                        u32x2 w0; w0.x = w.x; w0.y = w.y; u32x2 w1; w1.x = w.z; w1.y = w.w; *(u32x2*)gq = w0; *(u32x2*)(gq + 128) = w1;
                    } else *(u32x4*)(rp + bj * 128) = w;
                    if (colt < 1024) { const int rq68 = row / 68, rm68 = row - rq68 * 68; if (rm68 == 0 || rm68 == 67) *(u32x4*)(HALO + ((size_t)rq68 * 2 + (rm68 ? 1 : 0)) * 1024 + colt + bj * 128 + wc * 32 + 8 * fq) = w; } } }
    }
};
struct EpiMerge { static constexpr int HOOK_T = 4; static constexpr bool PERM = false; const bf16_t* PG; bf16_t* H; int row0; float* PP;
    DI void mid(AccT& acc, const Unit& u, int br, int wr, int wc, int fr, int fq) const {
        const bf16_t* gp = PG + ((size_t)u.pm * 16 + br * 4 + u.pn) * 65536 + (wr * 4 + wc) * 512 + (fr + 16 * fq) * 8;
#pragma unroll
        for (int ai = 0; ai < 2; ++ai)
#pragma unroll
            for (int mp = 0; mp < 2; ++mp) {
                u32x4 fn[2][2], fo[2][2];
#pragma unroll
                for (int mm = 0; mm < 2; ++mm)
#pragma unroll
                    for (int bj = 0; bj < 2; ++bj) { const int o = ((ai * 4 + 2 * mp + mm) * 2 + bj) * 4096; fn[mm][bj] = *(const u32x4*)(gp + o); fo[mm][bj] = *(const u32x4*)(gp + o - 4 * 65536); }
                asm volatile("" ::: "memory");
#pragma unroll
                for (int mm = 0; mm < 2; ++mm)
#pragma unroll
                    for (int bj = 0; bj < 2; ++bj) {
                        { u32x2 a; a.x = fn[mm][bj].x; a.y = fn[mm][bj].y; u32x2 c; c.x = fo[mm][bj].x; c.y = fo[mm][bj].y; const f32x4 en = bf4(a), eo = bf4(c);
#pragma unroll
                          for (int q = 0; q < 4; ++q) acc[ai][bj][2 * mp + mm][0][q] *= en[q] * rcpf_(eo[q]); }
                        __builtin_amdgcn_sched_barrier(0);
                        { u32x2 a; a.x = fn[mm][bj].z; a.y = fn[mm][bj].w; u32x2 c; c.x = fo[mm][bj].z; c.y = fo[mm][bj].w; const f32x4 en = bf4(a), eo = bf4(c);
#pragma unroll
                          for (int q = 0; q < 4; ++q) acc[ai][bj][2 * mp + mm][1][q] *= en[q] * rcpf_(eo[q]); }
                        __builtin_amdgcn_sched_barrier(0); }
            }
    }
    DI void operator()(const AccT& acc, const Unit& u, int wr, int wc, int fr, int fq) const {
        if (u.aux >= 8) {
            const int br = u.aux & 3;
            const bf16_t* gq = PG + ((size_t)u.pm * 16 + br * 4 + u.pn) * 65536 + (wr * 4 + wc) * 512 + (fr + 16 * fq) * 8;
            float* pp = PP + (size_t)((u.aux >> 4) * 4 + br) * 65536 + (wr * 4 + wc) * 512 + (fr + 16 * fq) * 8;
#pragma unroll
            for (int ai = 0; ai < 2; ++ai)
#pragma unroll
                for (int m = 0; m < 4; ++m) {
                    u32x4 f[2];
#pragma unroll
                    for (int bj = 0; bj < 2; ++bj) f[bj] = *(const u32x4*)(gq + ((ai * 4 + m) * 2 + bj) * 4096);
                    asm volatile("" ::: "memory");
#pragma unroll
                    for (int bj = 0; bj < 2; ++bj)
#pragma unroll
                        for (int n = 0; n < 2; ++n) { u32x2 c; c.x = n ? f[bj].z : f[bj].x; c.y = n ? f[bj].w : f[bj].y; const f32x4 e = bf4(c); const f32x4 a = acc[ai][bj][m][n];
                            *(f32x4*)(pp + ((ai * 4 + m) * 2 + bj) * 4096 + 4 * n) = (f32x4){a[0] * rcpf_(e[0]), a[1] * rcpf_(e[1]), a[2] * rcpf_(e[2]), a[3] * rcpf_(e[3])}; }
                }
            return;
        }
        const bf16_t* gp = PG + ((size_t)u.pm * 16 + 3 * 4 + u.pn) * 65536 + (wr * 4 + wc) * 512 + (fr + 16 * fq) * 8;
#pragma unroll
        for (int ai = 0; ai < 2; ++ai)
#pragma unroll
            for (int mp = 0; mp < 2; ++mp) {
                u32x4 f[2][2];
#pragma unroll
                for (int mm = 0; mm < 2; ++mm)
#pragma unroll
                    for (int bj = 0; bj < 2; ++bj) f[mm][bj] = *(const u32x4*)(gp + ((ai * 4 + 2 * mp + mm) * 2 + bj) * 4096);
                asm volatile("" ::: "memory");
#pragma unroll
                for (int mm = 0; mm < 2; ++mm) { const int m = 2 * mp + mm, row = u.pm * 256 + ai * 128 + wr * 64 + m * 16 + fr; unsigned char* yp = (unsigned char*)H + (size_t)(row0 + row) * D + u.pn * 256 + wc * 32 + 4 * fq;
#pragma unroll
                    for (int bj = 0; bj < 2; ++bj)
#pragma unroll
                        for (int n = 0; n < 2; ++n) { u32x2 c; c.x = n ? f[mm][bj].z : f[mm][bj].x; c.y = n ? f[mm][bj].w : f[mm][bj].y; const f32x4 e = bf4(c); const f32x4 a = acc[ai][bj][m][n];
                            *(unsigned*)(yp + bj * 128 + n * 16) = pk_fp8x4(a[0] * rcpf_(e[0]), a[1] * rcpf_(e[1]), a[2] * rcpf_(e[2]), a[3] * rcpf_(e[3])); } }
            }
    }
};
struct EpiOut { static constexpr int HOOK_T = 0; static constexpr bool PERM = false; const float* xin; const float* cin; float* out; float* xc; const float* modl; int l;
    DI void operator()(AccT& acc, const Unit& u, int wr, int wc, int fr, int fq) const {
        const int b = u.pm / 17, tb = u.pm % 17; const bool isctx = tb == 0;
        const float* ga = modl + (size_t)(isctx ? 8 : b) * 6144 + 2048 + u.pn * 256 + wc * 32 + 4 * fq;
        f32x4 gv[2][2];
#pragma unroll
        for (int bj = 0; bj < 2; ++bj)
#pragma unroll
            for (int n = 0; n < 2; ++n) gv[bj][n] = ld4(ga + bj * 128 + n * 16);
#pragma unroll
        for (int ai = 0; ai < 2; ++ai)
#pragma unroll
            for (int bj = 0; bj < 2; ++bj)
#pragma unroll
                for (int m = 0; m < 4; ++m)
#pragma unroll
                    for (int n = 0; n < 2; ++n) acc[ai][bj][m][n] *= gv[bj][n];
        asm volatile("" ::: "memory");
        const size_t tro = (isctx ? (size_t)b * CTX : (size_t)b * SEQ + (tb - 1) * 256) * D + u.pn * 256;
        const float* sb = (isctx ? cin : (l == 0 ? xin : (const float*)out)) + tro; float* db = (isctx ? xc : out) + tro;
        const int lo = (wr * 64 + fr) * D + wc * 32 + 4 * fq;
        f32x4 rv[2][2][2];
#pragma unroll
        for (int bj = 0; bj < 2; ++bj)
#pragma unroll
            for (int n = 0; n < 2; ++n) rv[0][bj][n] = ld4(sb + lo + bj * 128 + n * 16);
#pragma unroll
        for (int k = 0; k < 8; ++k) {
            if (k + 1 < 8) {
#pragma unroll
                for (int bj = 0; bj < 2; ++bj)
#pragma unroll
                    for (int n = 0; n < 2; ++n) rv[(k + 1) & 1][bj][n] = ld4(sb + lo + (((k + 1) >> 2) * 128 + ((k + 1) & 3) * 16) * D + bj * 128 + n * 16); }
            asm volatile("" ::: "memory");
#pragma unroll
            for (int bj = 0; bj < 2; ++bj)
#pragma unroll
                for (int n = 0; n < 2; ++n) *(f32x4*)(db + lo + ((k >> 2) * 128 + (k & 3) * 16) * D + bj * 128 + n * 16) = rv[k & 1][bj][n] + acc[k >> 2][bj][k & 3][n];
            asm volatile("" ::: "memory");
        }
    }
};
struct EpiGate { static constexpr int HOOK_T = 0; static constexpr bool PERM = true; bf16_t* PG;
    DI void operator()(const AccT& acc, const Unit& u, int wr, int wc, int fr, int fq) const {
#pragma unroll
        for (int ai = 0; ai < 2; ++ai)
#pragma unroll
            for (int m = 0; m < 4; ++m) { const int row = u.pm * 256 + ai * 128 + wr * 64 + m * 16 + fr; bf16_t* rp = PG + (size_t)row * NPG + u.pn * 256 + wc * 32 + 8 * fq;
#pragma unroll
                for (int bj = 0; bj < 2; ++bj) { float e[8];
#pragma unroll
                    for (int q = 0; q < 4; ++q) { e[q] = 1.f + __expf(-fminf(fmaxf(acc[ai][bj][m][0][q], -10.f), 10.f)); e[4 + q] = 1.f + __expf(-fminf(fmaxf(acc[ai][bj][m][1][q], -10.f), 10.f)); }
                    u32x4 w; w.x = pk2(e[0], e[1]); w.y = pk2(e[2], e[3]); w.z = pk2(e[4], e[5]); w.w = pk2(e[6], e[7]); *(u32x4*)(rp + bj * 128) = w; } }
    }
};
struct EpiUp { static constexpr int HOOK_T = 0; static constexpr bool PERM = true; unsigned char* hmid;
    DI void operator()(const AccT& acc, const Unit& u, int wr, int wc, int fr, int fq) const {
#pragma unroll
        for (int ai = 0; ai < 2; ++ai)
#pragma unroll
            for (int m = 0; m < 4; ++m) { const int row = u.pm * 256 + ai * 128 + wr * 64 + m * 16 + fr;
                float o[8];
#pragma unroll
                for (int n = 0; n < 2; ++n)
#pragma unroll
                    for (int j = 0; j < 4; ++j) o[n * 4 + j] = siluf_(acc[ai][0][m][n][j]) * acc[ai][1][m][n][j];
                u32x2 w; w.x = pk_fp8x4(o[0], o[1], o[2], o[3]); w.y = pk_fp8x4(o[4], o[5], o[6], o[7]);
                *(u32x2*)(hmid + (size_t)row * 512 + u.aux * 128 + wc * 32 + 8 * fq) = w; }
    }
};
struct EpiDown { static constexpr int HOOK_T = 0; static constexpr bool PERM = true; unsigned char* ys;
    DI void operator()(const AccT& acc, const Unit& u, int wr, int wc, int fr, int fq) const {
#pragma unroll
        for (int ai = 0; ai < 2; ++ai)
#pragma unroll
            for (int m = 0; m < 4; ++m) { const int row = u.pm * 256 + ai * 128 + wr * 64 + m * 16 + fr; unsigned char* rp = ys + (size_t)row * 1024 + u.aux * 256 + wc * 32 + 8 * fq;
#pragma unroll
                for (int bj = 0; bj < 2; ++bj) { const f32x4 v0 = acc[ai][bj][m][0] * 16.f, v1 = acc[ai][bj][m][1] * 16.f; u32x2 w; w.x = pk_fp8x4(v0[0], v0[1], v0[2], v0[3]); w.y = pk_fp8x4(v1[0], v1[1], v1[2], v1[3]); *(u32x2*)(rp + bj * 128) = w; } }
    }
};


DI int qpop(const int tid, unsigned* ctr, LAS int* slot) {
    __syncthreads();
    if (tid == 0) *slot = (int)__hip_atomic_fetch_add(ctr, 1u, __ATOMIC_RELAXED, __HIP_MEMORY_SCOPE_AGENT);
    __syncthreads();
    return __builtin_amdgcn_readfirstlane(*slot);
}
template <int QM>
DI void q_prep(const Ctx& X, int l, bf16x8 (&qf)[4], int h, bool isctx, int t) {
    float x[4][8];
#pragma unroll
    for (int s = 0; s < 4; ++s) { const u32x4 v = __builtin_bit_cast(u32x4, qf[s]);
#pragma unroll
        for (int j = 0; j < 4; ++j) { x[s][2 * j] = bflo(v[j]); x[s][2 * j + 1] = bfhi(v[j]); } }
    if (QM == 0) {
        float ss = 0.f;
#pragma unroll
        for (int s = 0; s < 4; ++s)
#pragma unroll
            for (int j = 0; j < 8; ++j) ss += x[s][j] * x[s][j];
        ss += __shfl_xor(ss, 32);
        const float rr = rsqrtf(ss * (1.f / 64.f) + EPS);
        const float* gw = X.kp->in[I_QNORM] + l * 64 + 8 * h;
#pragma unroll
        for (int s = 0; s < 4; ++s) { const f32x4 w0 = ld4(gw + 16 * s), w1 = ld4(gw + 16 * s + 4);
#pragma unroll
            for (int j = 0; j < 4; ++j) { x[s][j] = x[s][j] * rr * w0[j]; x[s][4 + j] = x[s][4 + j] * rr * w1[j]; } }
    }
    if (QM <= 1 && !isctx) {
        const float* rope = (const float*)(X.ws + OFF_rope);
#pragma unroll
        for (int s = 0; s < 4; ++s) { const int pos = s < 2 ? (t >> 6) : (t & 63); const float* rp = rope + (pos * 16 + (s & 1) * 8 + 4 * h) * 2;
            const f32x4 c0 = ld4(rp), c1 = ld4(rp + 4);
#pragma unroll
            for (int jj = 0; jj < 4; ++jj) { const float cs = jj < 2 ? c0[2 * jj] : c1[2 * (jj - 2)], sn = jj < 2 ? c0[2 * jj + 1] : c1[2 * (jj - 2) + 1];
                const float y0 = x[s][2 * jj] * cs - x[s][2 * jj + 1] * sn, y1 = x[s][2 * jj] * sn + x[s][2 * jj + 1] * cs; x[s][2 * jj] = y0; x[s][2 * jj + 1] = y1; } }
    }
#pragma unroll
    for (int s = 0; s < 4; ++s) { u32x4 v;
#pragma unroll
        for (int j = 0; j < 4; ++j) v[j] = pk2(x[s][2 * j] * (0.125f * 1.4426950408889634f), x[s][2 * j + 1] * (0.125f * 1.4426950408889634f));
        qf[s] = __builtin_bit_cast(bf16x8, v); }
}
DI int clampi(int v, int lo, int hi) { return v < lo ? lo : (v > hi ? hi : v); }
DI float bfe(const u32x4& v, int j) { return (j & 1) ? bfhi(v[j >> 1]) : bflo(v[j >> 1]); }

struct NbrLane { int kb0; unsigned tb, nb; int r0; };
template <int TYPE>
DI void attn_x1(const LAS unsigned char* Ks, const LAS float* biasL, const int ti, const int loc0, const int c0, const int tq, const int qr, const int qc, const int r, const int h,
                const int vb, const bf16x8 (&qf)[4], f32x16& s0, f32x16& s1, float& mx, s16x4 (&vl)[2][2][2], s16x4 (&vh)[2][2][2], const NbrLane& nl) {
    const bool local = ti >= 4; const int lt = loc0 + ti - 4;
    if (TYPE == 2 && local) {
#pragma unroll
        for (int i = 0; i < 16; ++i) s0[i] = 0.f;
#pragma unroll
        for (int s = 0; s < 4; ++s) { const bf16x8 a0 = *(const LAS bf16x8*)(Ks + (nl.kb0 + r) * 144 + 32 * s + 16 * h); s0 = mfma32(a0, qf[s], s0); }
        const int vbh = vb + nl.kb0 * 192;
#pragma unroll
        for (int s2 = 0; s2 < 2; ++s2)
#pragma unroll
            for (int dt = 0; dt < 2; ++dt) {
                asm volatile("ds_read_b64_tr_b16 %0, %1 offset:%2" : "=&v"(vl[0][s2][dt]) : "v"(vbh), "i"((16 * s2) * 192 + 64 * dt) : "memory");
                asm volatile("ds_read_b64_tr_b16 %0, %1 offset:%2" : "=&v"(vh[0][s2][dt]) : "v"(vbh), "i"((16 * s2 + 8) * 192 + 64 * dt) : "memory");
            }
        const int dr = lt - qr + 7; const bool rv = lt >= nl.r0 && lt < nl.r0 + 8;
        const LAS unsigned char* ba = (const LAS unsigned char*)(size_t)(rv ? nl.tb + (unsigned)(dr * 4096) : nl.nb);
        mx = -1.0e30f;
#pragma unroll
        for (int i = 0; i < 16; ++i) { s0[i] += *(const LAS float*)(ba + ((i & 3) + 8 * (i >> 2)) * 4); mx = fmaxf(mx, s0[i]); }
        mx = fmaxf(mx, __shfl_xor(mx, 32));
        return;
    }
#pragma unroll
    for (int i = 0; i < 16; ++i) { s0[i] = 0.f; s1[i] = 0.f; }
#pragma unroll
    for (int s = 0; s < 4; ++s) {
        const bf16x8 a0 = *(const LAS bf16x8*)(Ks + r * 144 + 32 * s + 16 * h), a1 = *(const LAS bf16x8*)(Ks + (32 + r) * 144 + 32 * s + 16 * h);
        s0 = mfma32(a0, qf[s], s0); s1 = mfma32(a1, qf[s], s1);
    }
#pragma unroll
    for (int kt = 0; kt < 2; ++kt)
#pragma unroll
        for (int s2 = 0; s2 < 2; ++s2)
#pragma unroll
            for (int dt = 0; dt < 2; ++dt) {
                asm volatile("ds_read_b64_tr_b16 %0, %1 offset:%2" : "=&v"(vl[kt][s2][dt]) : "v"(vb), "i"((32 * kt + 16 * s2) * 192 + 64 * dt) : "memory");
                asm volatile("ds_read_b64_tr_b16 %0, %1 offset:%2" : "=&v"(vh[kt][s2][dt]) : "v"(vb), "i"((32 * kt + 16 * s2 + 8) * 192 + 64 * dt) : "memory");
            }
    mx = -1.0e30f;
#pragma unroll
    for (int i = 0; i < 16; ++i) {
#pragma unroll
        for (int kt = 0; kt < 2; ++kt) {
            float s = kt ? s1[i] : s0[i];
            const int kidx = 32 * kt + (i & 3) + 8 * (i >> 2) + 4 * h;
            if (TYPE == 1 && local) { const int dlt = tq - (64 * lt + kidx); if (dlt > 128 || dlt < -128) s = -1.0e30f; }
            if (kt) s1[i] = s; else s0[i] = s;
            mx = fmaxf(mx, s);
        }
    }
    mx = fmaxf(mx, __shfl_xor(mx, 32));
}
template <bool HALF = false>
DI void attn_x2(f32x16& s0, f32x16& s1, const float mx, s16x4 (&vl)[2][2][2], s16x4 (&vh)[2][2][2], f32x16& ot0, f32x16& ot1, float& m_run, float& l_run) {
    if (!__all(mx <= m_run + 8.f)) {
        const float m_new = fmaxf(m_run, mx), alpha = __builtin_amdgcn_exp2f(m_run - m_new); m_run = m_new; l_run *= alpha;
#pragma unroll
        for (int i = 0; i < 16; ++i) { ot0[i] *= alpha; ot1[i] *= alpha; }
    }
    float ls = 0.f;
#pragma unroll
    for (int kt = 0; kt < (HALF ? 1 : 2); ++kt)
#pragma unroll
        for (int s2 = 0; s2 < 2; ++s2) {
            float p[8];
#pragma unroll
            for (int j = 0; j < 8; ++j) { p[j] = __builtin_amdgcn_exp2f((kt ? s1[8 * s2 + j] : s0[8 * s2 + j]) - m_run); ls += p[j]; }
            const bf16x8 pb = pack8(p[0], p[1], p[2], p[3], p[4], p[5], p[6], p[7]);
            ot0 = mfma32(__builtin_shufflevector(vl[kt][s2][0], vh[kt][s2][0], 0, 1, 2, 3, 4, 5, 6, 7), pb, ot0);
            ot1 = mfma32(__builtin_shufflevector(vl[kt][s2][1], vh[kt][s2][1], 0, 1, 2, 3, 4, 5, 6, 7), pb, ot1);
        }
    l_run += ls;
}

template <int TYPE>
DI void attn_item(const Ctx& X, int l, int item, bool ctxq) {
    const int tid = X.tid, lane = X.lane, wv = X.wv, r = lane & 31, h = lane >> 5;
    LAS unsigned char* KV = X.lds;
    LAS float* biasL = (LAS float*)(X.lds + 64512);
    const bf16_t* PA = (const bf16_t*)(X.ws + uo_projA(X.rs)); bf16_t* bc = (bf16_t*)(X.ws + uo_bcat(X.rs));
    int bl, head, kvh, tq, qr = 0, qc = 0, grp = 0, qt = 0;
    if (TYPE <= 1) { const int nq = ctxq ? 4 : 64; bl = item / (2 * nq); kvh = (item / nq) & 1; qt = item % nq; head = 4 * kvh + (wv >> 1); tq = qt * 64 + (wv & 1) * 32 + r; }
    else if (ctxq) { bl = item >> 3; head = item & 7; kvh = head; tq = wv * 32 + r; }
    else { bl = item >> 7; head = (item >> 4) & 7; kvh = head; grp = item & 15; qr = 4 * grp + 2 * (wv >> 2) + (r >> 4); qc = (wv & 3) * 16 + (r & 15); tq = qr * 64 + qc; }
    const int qcol = (TYPE == 0 ? C_GQ : TYPE == 1 ? C_WQ : C_NQ) + 64 * head, kcol = (TYPE == 0 ? C_GK : TYPE == 1 ? C_WK : C_NK) + 64 * kvh, vcol = (TYPE == 0 ? C_GV : TYPE == 1 ? C_WV : C_NV) + 64 * kvh;
    const int brow = bl * TPB, qrow = brow + (ctxq ? 0 : CTX) + tq;
    int nloc = 0, loc0 = 0;
    if (!ctxq) {
        if (TYPE == 0) { nloc = 64; }
        else if (TYPE == 1) { loc0 = qt - 2 < 0 ? 0 : qt - 2; nloc = (qt + 2 > 63 ? 63 : qt + 2) - loc0 + 1; }
        else { loc0 = clampi(4 * grp - 4, 0, 56); nloc = clampi(4 * grp - 1, 0, 56) + 7 - loc0 + 1; }
    }
    const int ntiles = 4 + nloc;
    const int c0 = clampi(qc - 8, 0, 48);
    const int qrA = 4 * grp + 2 * (wv >> 2), r0a = clampi(qrA - 4, 0, 56), r0b = clampi(qrA - 3, 0, 56);
    NbrLane nl = {0, 0u, 0u, 0};
    if (TYPE == 2 && !ctxq) {
        const float* rb = X.kp->in[I_RELB] + (size_t)(l * 8 + head) * 465;
        LAS float* rbl = biasL + 241 * 64;
        if (tid < 465) rbl[tid] = rb[tid] * 1.4426950408889634f;
        __syncthreads();
        for (int i = tid; i < 241 * 64; i += NTHR) { const int w = i & 63, row = i >> 6; float v = -1.0e30f;
            if (row < 240) { const int dr = row >> 4, sh = (row & 15) - 7, rel = w - 16; if (rel >= 7 + sh && rel < 23 + sh) v = rbl[dr * 31 + rel]; }
            biasL[i] = v; }
        const int j = wv & 3; nl.kb0 = j == 0 ? 0 : (j == 1 ? 8 : (j == 2 ? 24 : 32)); nl.r0 = clampi(qr - 4, 0, 56);
        const int sh = c0 - (qc - 8) + 7, colw = nl.kb0 - qc + 15 + 16 + 4 * h;
        nl.tb = (unsigned)(size_t)biasL + (unsigned)((sh * 64 + colw) * 4); nl.nb = (unsigned)(size_t)biasL + (unsigned)((240 * 64 + colw) * 4);
    }
    bf16x8 qf[4];
#pragma unroll
    for (int s = 0; s < 4; ++s) qf[s] = *(const bf16x8*)(PA + (size_t)qrow * NPA + qcol + 16 * s + 8 * h);
    q_prep<TYPE>(X, l, qf, h, ctxq, tq);
    f32x16 ot0, ot1;
#pragma unroll
    for (int i = 0; i < 16; ++i) { ot0[i] = 0.f; ot1[i] = 0.f; }
    float m_run = -1.0e30f, l_run = 0.f;
    if (TYPE == 1) { m_run = X.kp->in[I_SINK][l * 8 + head] * 1.4426950408889634f; l_run = h == 0 ? 1.f : 0.f; }
    int tidk = tid; asm volatile("" : "+v"(tidk)); const int skey = tidk >> 3, sdp = tidk & 7;
    const unsigned vb0 = (unsigned)(size_t)KV + 9216u + (unsigned)((4 * h + ((lane & 15) >> 2)) * 192 + (16 * ((lane >> 4) & 1) + 4 * (lane & 3)) * 2);
    u32x4 kregA, vregA, kregB, vregB, kregC, vregC;
#define ATT_LOAD(tn, kreg, vreg) do { const int trow_ = brow + ((tn) < 4 ? 64 * (tn) : CTX + 64 * (loc0 + (tn) - 4)); const size_t ro_ = (size_t)(trow_ + skey) * NPA + sdp * 8; \
        kreg = *(const u32x4*)(PA + ro_ + kcol); vreg = *(const u32x4*)(PA + ro_ + vcol); } while (0)
#define ATT_STORE(buf, kreg, vreg) do { LAS unsigned char* Ks_ = KV + (buf) * 21504; *(LAS u32x4*)(Ks_ + skey * 144 + sdp * 16) = kreg; *(LAS u32x4*)(Ks_ + 9216 + skey * 192 + sdp * 16) = vreg; } while (0)
#define ATT_BARRIER() do { asm volatile("s_waitcnt lgkmcnt(0)" ::: "memory"); __builtin_amdgcn_s_barrier(); asm volatile("" ::: "memory"); } while (0)
    ATT_LOAD(0, kregA, vregA); ATT_LOAD(1, kregB, vregB); ATT_LOAD(2, kregC, vregC);
    ATT_STORE(0, kregA, vregA);
    ATT_LOAD(3, kregA, vregA);
    ATT_BARRIER();
    f32x16 s0, s1; float mx = 0.f; s16x4 vl[2][2][2], vh[2][2][2];
    int bcur = 0;
#define ATT_ACTIVE(t) (!(TYPE == 2 && (t) >= 4) || ((loc0 + (t) - 4 >= r0a) && (loc0 + (t) - 4 < r0b + 8)))
#define ATT_TILE(ti, kreg, vreg) do { const int bn_ = bcur == 2 ? 0 : bcur + 1; \
        if ((ti) + 1 < ntiles) ATT_STORE(bn_, kreg, vreg); \
        if ((ti) + 4 < ntiles) ATT_LOAD((ti) + 4, kreg, vreg); \
        const bool act_ = ATT_ACTIVE(ti); \
        if (act_) attn_x1<TYPE>(KV + bcur * 21504, biasL, (ti), loc0, c0, tq, qr, qc, r, h, (int)(vb0 + (unsigned)(bcur * 21504)), qf, s0, s1, mx, vl, vh, nl); \
        if (TYPE == 2 && (ti) >= 4) { asm volatile("s_waitcnt lgkmcnt(0)" ::: "memory"); __builtin_amdgcn_sched_barrier(0); } else ATT_BARRIER();        \
        if (act_) { if (TYPE == 2 && (ti) >= 4) attn_x2<true>(s0, s1, mx, vl, vh, ot0, ot1, m_run, l_run); else attn_x2<false>(s0, s1, mx, vl, vh, ot0, ot1, m_run, l_run); } \
        ATT_BARRIER(); bcur = bn_; } while (0)
    for (int ti = 0; ti < ntiles; ti += 3) {
        ATT_TILE(ti, kregB, vregB);
        if (ti + 1 < ntiles) ATT_TILE(ti + 1, kregC, vregC);
        if (ti + 2 < ntiles) ATT_TILE(ti + 2, kregA, vregA);
    }
#undef ATT_ACTIVE
#undef ATT_TILE
#undef ATT_LOAD
#undef ATT_STORE
#undef ATT_BARRIER
    const float inv = rcpf_(l_run + __shfl_xor(l_run, 32));
    unsigned char* op = (unsigned char*)bc + (size_t)qrow * 2048 + 512 * (TYPE + 1) + 64 * head + 4 * h;
#pragma unroll
    for (int g4 = 0; g4 < 4; ++g4) {
        *(unsigned*)(op + 8 * g4) = pk_fp8x4(ot0[4 * g4] * inv, ot0[4 * g4 + 1] * inv, ot0[4 * g4 + 2] * inv, ot0[4 * g4 + 3] * inv);
        *(unsigned*)(op + 32 + 8 * g4) = pk_fp8x4(ot1[4 * g4] * inv, ot1[4 * g4 + 1] * inv, ot1[4 * g4 + 2] * inv, ot1[4 * g4 + 3] * inv);
    }
}

DI void g64_tile(const LAS unsigned char* Ks, const LAS unsigned char* Qw, const int r, const int h, const int vb, f32x16 (&ot)[2][2], float (&m_run)[2], float (&l_run)[2], const bool first) {
    f32x16 sc[2][2];
#pragma unroll
    for (int g = 0; g < 2; ++g)
#pragma unroll
        for (int i = 0; i < 16; ++i) { sc[g][0][i] = 0.f; sc[g][1][i] = 0.f; }
#pragma unroll
    for (int s = 0; s < 4; ++s) {
        const bf16x8 a0 = *(const LAS bf16x8*)(Ks + r * 144 + 32 * s + 16 * h), a1 = *(const LAS bf16x8*)(Ks + (32 + r) * 144 + 32 * s + 16 * h);
#pragma unroll
        for (int g = 0; g < 2; ++g) { const bf16x8 qv = *(const LAS bf16x8*)(Qw + (32 * g + r) * 144 + 32 * s + 16 * h); sc[g][0] = mfma32(a0, qv, sc[g][0]); sc[g][1] = mfma32(a1, qv, sc[g][1]); }
    }
    s16x4 vl[2][2], vh[2][2];
#define G64_TR(kt) do { _Pragma("unroll") for (int s2 = 0; s2 < 2; ++s2) _Pragma("unroll") for (int dt = 0; dt < 2; ++dt) { \
        asm volatile("ds_read_b64_tr_b16 %0, %1 offset:%2" : "=&v"(vl[s2][dt]) : "v"(vb), "i"((32 * (kt) + 16 * s2) * 192 + 64 * dt) : "memory"); \
        asm volatile("ds_read_b64_tr_b16 %0, %1 offset:%2" : "=&v"(vh[s2][dt]) : "v"(vb), "i"((32 * (kt) + 16 * s2 + 8) * 192 + 64 * dt) : "memory"); } } while (0)
    G64_TR(0);
#pragma unroll
    for (int g = 0; g < 2; ++g) {
        const float mm = m_run[g];
        float mxa = -3.0e38f, mxb = -3.0e38f;
#pragma unroll
        for (int kt = 0; kt < 2; ++kt)
#pragma unroll
            for (int jj = 0; jj < 8; ++jj) { const float t0 = sc[g][kt][2 * jj] - mm, t1 = sc[g][kt][2 * jj + 1] - mm; if (jj & 1) mxb = fmaxf(fmaxf(mxb, t0), t1); else mxa = fmaxf(fmaxf(mxa, t0), t1); sc[g][kt][2 * jj] = t0; sc[g][kt][2 * jj + 1] = t1; }
        float mx = fmaxf(mxa, mxb); mx = fmaxf(mx, __shfl_xor(mx, 32));
        if (first || !__all(mx <= 8.f)) {
            const float d = first ? mx : fmaxf(mx, 0.f), alpha = first ? 1.f : __builtin_amdgcn_exp2f(-d); m_run[g] += d; l_run[g] *= alpha;
#pragma unroll
            for (int i = 0; i < 16; ++i) { ot[g][0][i] *= alpha; ot[g][1][i] *= alpha; sc[g][0][i] -= d; sc[g][1][i] -= d; }
        }
    }
    float ls[2] = {0.f, 0.f};
#pragma unroll
    for (int kt = 0; kt < 2; ++kt) {
        bf16x8 pb[2][2];
#pragma unroll
        for (int s2 = 0; s2 < 2; ++s2)
#pragma unroll
            for (int g = 0; g < 2; ++g) { float p[8];
#pragma unroll
                for (int j = 0; j < 8; ++j) { p[j] = __builtin_amdgcn_exp2f(sc[g][kt][8 * s2 + j]); ls[g] += p[j]; }
                pb[s2][g] = pack8(p[0], p[1], p[2], p[3], p[4], p[5], p[6], p[7]); }
        asm volatile("s_waitcnt lgkmcnt(0)" ::: "memory"); __builtin_amdgcn_sched_barrier(0);
        bf16x8 va[2][2];
#pragma unroll
        for (int s2 = 0; s2 < 2; ++s2)
#pragma unroll
            for (int dt = 0; dt < 2; ++dt) va[s2][dt] = __builtin_shufflevector(vl[s2][dt], vh[s2][dt], 0, 1, 2, 3, 4, 5, 6, 7);
        if (kt == 0) { asm volatile("" : "+v"(va[0][0]), "+v"(va[0][1]), "+v"(va[1][0]), "+v"(va[1][1])); G64_TR(1); }
#pragma unroll
        for (int s2 = 0; s2 < 2; ++s2)
#pragma unroll
            for (int g = 0; g < 2; ++g) { ot[g][0] = mfma32(va[s2][0], pb[s2][g], ot[g][0]); ot[g][1] = mfma32(va[s2][1], pb[s2][g], ot[g][1]); }
    }
#undef G64_TR
    l_run[0] += ls[0]; l_run[1] += ls[1];
}

DI void attn_global64(const Ctx& X, int l, int item) {
    const int tid = X.tid, lane = X.lane, wv = X.wv, r = lane & 31, h = lane >> 5;
    LAS unsigned char* KV = X.lds;
    LAS unsigned char* Qw = X.lds + 43008 + wv * 9216;
    const bf16_t* PA = (const bf16_t*)(X.ws + uo_projA(X.rs)); bf16_t* bc = (bf16_t*)(X.ws + uo_bcat(X.rs));
    const int bl = item >> 6, kvh = (item >> 5) & 1, qt = item & 31, head = 4 * kvh + (wv >> 1);
    const int brow = bl * TPB, qrow0 = brow + CTX + qt * 128 + (wv & 1) * 64 + r;
    const int qcol = C_GQ + 64 * head, kcol = C_GK + 64 * kvh, vcol = C_GV + 64 * kvh;
#pragma unroll 1
    for (int g = 0; g < 2; ++g) { bf16x8 qf[4];
#pragma unroll
        for (int s = 0; s < 4; ++s) qf[s] = *(const bf16x8*)(PA + (size_t)(qrow0 + 32 * g) * NPA + qcol + 16 * s + 8 * h);
        q_prep<0>(X, l, qf, h, false, qt * 128 + (wv & 1) * 64 + 32 * g + r);
#pragma unroll
        for (int s = 0; s < 4; ++s) *(LAS bf16x8*)(Qw + (32 * g + r) * 144 + 32 * s + 16 * h) = qf[s]; }
    f32x16 ot[2][2];
#pragma unroll
    for (int g = 0; g < 2; ++g)
#pragma unroll
        for (int i = 0; i < 16; ++i) { ot[g][0][i] = 0.f; ot[g][1][i] = 0.f; }
    float m_run[2] = {0.f, 0.f}, l_run[2] = {0.f, 0.f};
    int tidk = tid; asm volatile("" : "+v"(tidk)); const int skey = tidk >> 3, sdp = tidk & 7;
    const unsigned vb0 = (unsigned)(size_t)KV + 9216u + (unsigned)((4 * h + ((lane & 15) >> 2)) * 192 + (16 * ((lane >> 4) & 1) + 4 * (lane & 3)) * 2);
    u32x4 kregA, vregA, kregB, vregB;
#define ATT_LOAD(tn, kreg, vreg) do { const size_t ro_ = (size_t)(brow + 64 * (tn) + skey) * NPA + sdp * 8; kreg = *(const u32x4*)(PA + ro_ + kcol); vreg = *(const u32x4*)(PA + ro_ + vcol); } while (0)
#define ATT_STORE(buf, kreg, vreg) do { LAS unsigned char* Ks_ = KV + (buf) * 21504; *(LAS u32x4*)(Ks_ + skey * 144 + sdp * 16) = kreg; *(LAS u32x4*)(Ks_ + 9216 + skey * 192 + sdp * 16) = vreg; } while (0)
#define ATT_BARRIER() do { asm volatile("s_waitcnt lgkmcnt(0)" ::: "memory"); __builtin_amdgcn_s_barrier(); asm volatile("" ::: "memory"); } while (0)
    constexpr int ntiles = TPB / 64;
    ATT_LOAD(0, kregA, vregA); ATT_STORE(0, kregA, vregA);
    ATT_LOAD(1, kregA, vregA); ATT_LOAD(2, kregB, vregB);
    ATT_BARRIER();
#define ATT_TILE(ti, kreg, vreg) do { \
        if ((ti) + 1 < ntiles) ATT_STORE(((ti) + 1) & 1, kreg, vreg); \
        if ((ti) + 3 < ntiles) ATT_LOAD((ti) + 3, kreg, vreg); \
        g64_tile(KV + ((ti) & 1) * 21504, Qw, r, h, (int)(vb0 + (unsigned)(((ti) & 1) * 21504)), ot, m_run, l_run, (ti) == 0); \
        ATT_BARRIER(); } while (0)
    for (int ti = 0; ti < ntiles; ti += 2) { ATT_TILE(ti, kregA, vregA); ATT_TILE(ti + 1, kregB, vregB); }
#undef ATT_TILE
#undef ATT_LOAD
#undef ATT_STORE
#undef ATT_BARRIER
#pragma unroll
    for (int g = 0; g < 2; ++g) {
        const float inv = rcpf_(l_run[g] + __shfl_xor(l_run[g], 32));
        unsigned char* op = (unsigned char*)bc + (size_t)(qrow0 + 32 * g) * 2048 + 512 + 64 * head + 4 * h;
#pragma unroll
        for (int g4 = 0; g4 < 4; ++g4) {
            *(unsigned*)(op + 8 * g4) = pk_fp8x4(ot[g][0][4 * g4] * inv, ot[g][0][4 * g4 + 1] * inv, ot[g][0][4 * g4 + 2] * inv, ot[g][0][4 * g4 + 3] * inv);
            *(unsigned*)(op + 32 + 8 * g4) = pk_fp8x4(ot[g][1][4 * g4] * inv, ot[g][1][4 * g4 + 1] * inv, ot[g][1][4 * g4 + 2] * inv, ot[g][1][4 * g4 + 3] * inv);
        }
    }
}

DI void chain_item(const Ctx& X, int l, int bg0, int item) {
    const int tid = X.tid, lane = X.lane, wv = X.wv;
    const int bl = item >> 3, head = (item >> 1) & 3, dir = item & 1, b = bg0 + bl;
    LAS unsigned char* L = X.lds;
    constexpr int QS = 0, KS = 17408, KTS = 34816, VTS = 53248, CTS = 76288, SCU = 119808, SCM = SCU + 256, SCI = SCM + 256, SCF = SCI + 256;
    constexpr float LOG2E = 1.4426950408889634f;
    const bf16_t* PA = (const bf16_t*)(X.ws + uo_projA(X.rs)); bf16_t* hp = (bf16_t*)(X.ws + uo_hpart(X.rs));
    const float* gI = (const float*)(X.ws + OFF_gI); const float* gF = (const float*)(X.ws + OFF_gF);
    for (int i = tid; i < 43520 / 4; i += NTHR) ((LAS unsigned*)(L + CTS))[i] = 0u;
    for (int i = tid; i < 32 * 144 / 4; i += NTHR) ((LAS unsigned*)(L + VTS + 128 * 144))[i] = (i < 36) ? 0x3F803F80u : 0u;
    f32x16 ct0, ct1, ct2;
#pragma unroll
    for (int i = 0; i < 16; ++i) { ct0[i] = 0.f; ct1[i] = 0.f; ct2[i] = 0.f; }
    float m_run = -1.0e30f;
    u32x4 rq[2], rk[2], rv[2]; float ric, rfc;
    const unsigned loff0 = (unsigned)(tid >> 4) * (NPA * 2) + (unsigned)(tid & 15) * 16;
#define CHAIN_LOAD(stepn) do { const int seg_ = (stepn) >= 4 ? 1 : 0, cpo_ = seg_ ? (stepn) - 4 : (stepn), seglen_ = seg_ ? SEQ : CTX, segrow0_ = bl * TPB + (seg_ ? CTX : 0); \
        _Pragma("unroll") for (int it = 0; it < 2; ++it) { const int pp_ = cpo_ * 64 + (tid >> 4) + 32 * it, tk_ = dir ? seglen_ - 1 - pp_ : pp_; \
            const bf16_t* rp_ = PA + (size_t)(segrow0_ + tk_) * NPA + head * 128 + (tid & 15) * 8; \
            rq[it] = *(const u32x4*)(rp_ + C_MQ); rk[it] = *(const u32x4*)(rp_ + C_MK); rv[it] = *(const u32x4*)(rp_ + C_MV); } \
        { const int pp_ = cpo_ * 64 + lane, tk_ = dir ? seglen_ - 1 - pp_ : pp_, tt_ = (seg_ ? CTX : 0) + tk_; const size_t gi_ = ((size_t)(dir * NB + b) * 4 + head) * TPB + tt_; ric = gI[gi_]; rfc = gF[gi_]; } } while (0)
    (void)loff0;
#define CH_BARRIER() do { asm volatile("s_waitcnt lgkmcnt(0)" ::: "memory"); __builtin_amdgcn_s_barrier(); asm volatile("" ::: "memory"); } while (0)
    CHAIN_LOAD(0);
    __syncthreads();
    for (int step = 0; step < 68; ++step) {
        const int seg = step >= 4 ? 1 : 0, cpo = seg ? step - 4 : step, seglen = seg ? SEQ : CTX, segrow0 = bl * TPB + (seg ? CTX : 0);
        float decay, wgv;
        {
            float bb = rfc;
#pragma unroll
            for (int o = 1; o < 64; o <<= 1) { const float t = __shfl_up(bb, o); if (lane >= o) bb += t; }
            const float u = ric - bb; float pm = u;
#pragma unroll
            for (int o = 1; o < 64; o <<= 1) { const float t = __shfl_up(pm, o); if (lane >= o) pm = fmaxf(pm, t); }
            const float Mv = fmaxf(pm, m_run), bend = __shfl(bb, 63), Mend = __shfl(Mv, 63);
            wgv = __expf(u - Mend); decay = __expf(m_run - Mend);
            if (wv == 0) { ((LAS float*)(L + SCU))[lane] = u * LOG2E; ((LAS float*)(L + SCM))[lane] = Mv * LOG2E; ((LAS float*)(L + SCI))[lane] = __expf(m_run - Mv); ((LAS float*)(L + SCF))[lane] = __expf(-(bb + Mv)); }
            m_run = bend + Mend;
        }
        {
            int tid_ = tid; asm volatile("" : "+v"(tid_)); const int sp0 = tid_ >> 4, sdp = tid_ & 15;
#pragma unroll
            for (int it = 0; it < 2; ++it) {
                const int p = sp0 + 32 * it; const float wg = __shfl(wgv, p);
                *(LAS u32x4*)(L + QS + p * 272 + sdp * 16) = rq[it]; *(LAS u32x4*)(L + KS + p * 272 + sdp * 16) = rk[it];
                u32x4 ks; ks.x = pk2(bflo(rk[it].x) * wg, bfhi(rk[it].x) * wg); ks.y = pk2(bflo(rk[it].y) * wg, bfhi(rk[it].y) * wg); ks.z = pk2(bflo(rk[it].z) * wg, bfhi(rk[it].z) * wg); ks.w = pk2(bflo(rk[it].w) * wg, bfhi(rk[it].w) * wg);
                const u32x4 v1 = rv[it];
#pragma unroll
                for (int j = 0; j < 8; ++j) {
                    *(LAS bf16_t*)(L + KTS + (sdp * 8 + j) * 144 + ((p * 2) ^ ((sdp & 7) << 4))) = (bf16_t)((j & 1) ? (ks[j >> 1] >> 16) : (ks[j >> 1] & 0xffffu));
                    *(LAS bf16_t*)(L + VTS + (sdp * 8 + j) * 144 + ((p * 2) ^ ((sdp & 7) << 4))) = (bf16_t)((j & 1) ? (v1[j >> 1] >> 16) : (v1[j >> 1] & 0xffffu));
                }
            }
        }
        CH_BARRIER();
        if (step + 1 < 68) CHAIN_LOAD(step + 1);
        {
            int lane_ = lane; asm volatile("" : "+v"(lane_)); const int r = lane_ & 31, h = lane_ >> 5;
            const int j = wv & 1, i = wv >> 1, t = 32 * j + r;
            const float Mt = ((const LAS float*)(L + SCM))[t], itr = ((const LAS float*)(L + SCI))[t], fl = ((const LAS float*)(L + SCF))[t];
            const int vsw = (((32 * i + r) >> 3) & 7) << 4;
            bf16x8 qf[8];
#pragma unroll
            for (int ks = 0; ks < 8; ++ks) qf[ks] = *(const LAS bf16x8*)(L + QS + t * 272 + 32 * ks + 16 * h);
            f32x16 st, nt, et;
#pragma unroll
            for (int q = 0; q < 16; ++q) { st[q] = 0.f; nt[q] = 0.f; et[q] = 0.f; }
#pragma unroll
            for (int ks = 0; ks < 8; ++ks) {
                nt = mfma32(*(const LAS bf16x8*)(L + CTS + (32 * i + r) * 272 + 32 * ks + 16 * h), qf[ks], nt);
                st = mfma32(*(const LAS bf16x8*)(L + KS + r * 272 + 32 * ks + 16 * h), qf[ks], st);
                et = mfma32(*(const LAS bf16x8*)(L + CTS + (128 + r) * 272 + 32 * ks + 16 * h), qf[ks], et);
            }
            const float qn = et[0] + __shfl_xor(et[0], 32);
#pragma unroll
            for (int q = 0; q < 16; ++q) nt[q] *= itr;
            float rsum = 0.f;
#pragma unroll
            for (int si = 0; si < 2; ++si) {
                if (si <= j) {
                    if (si == 1) {
#pragma unroll
                        for (int q = 0; q < 16; ++q) st[q] = 0.f;
#pragma unroll
                        for (int ks = 0; ks < 8; ++ks) st = mfma32(*(const LAS bf16x8*)(L + KS + (32 + r) * 272 + 32 * ks + 16 * h), qf[ks], st);
                    }
                    const bool diag = (si == j);
#pragma unroll
                    for (int g4 = 0; g4 < 4; ++g4) {
                        const f32x4 u0 = *(const LAS f32x4*)(L + SCU + (32 * si + 8 * g4 + 4 * h) * 4);
#pragma unroll
                        for (int q = 0; q < 4; ++q) { const int sa = 32 * si + 8 * g4 + 4 * h + q; float e0 = __builtin_amdgcn_exp2f(u0[q] - Mt); if (diag && sa > t) e0 = 0.f; st[4 * g4 + q] *= e0; rsum += st[4 * g4 + q]; }
                    }
#pragma unroll
                    for (int s2 = 0; s2 < 2; ++s2) {
                        const bf16x8 pb = pack8(st[8 * s2], st[8 * s2 + 1], st[8 * s2 + 2], st[8 * s2 + 3], st[8 * s2 + 4], st[8 * s2 + 5], st[8 * s2 + 6], st[8 * s2 + 7]);
                        const int ko = (32 * si + 16 * s2 + 4 * h) * 2;
                        const s16x4 lo = *(const LAS s16x4*)(L + VTS + (32 * i + r) * 144 + (ko ^ vsw)), hi = *(const LAS s16x4*)(L + VTS + (32 * i + r) * 144 + ((ko + 16) ^ vsw));
                        nt = mfma32(__builtin_shufflevector(lo, hi, 0, 1, 2, 3, 4, 5, 6, 7), pb, nt);
                    }
                }
            }
            rsum += __shfl_xor(rsum, 32);
            const float den = rsum + itr * qn, inv = rcpf_(fmaxf(fabsf(den), fl));
            const int pp = cpo * 64 + t, tk = dir ? seglen - 1 - pp : pp;
            bf16_t* op = hp + ((size_t)dir * X.rs + segrow0 + tk) * 512 + head * 128 + 32 * i + 4 * h;
#pragma unroll
            for (int g4 = 0; g4 < 4; ++g4) { u32x2 w; w.x = pk2(nt[4 * g4] * inv, nt[4 * g4 + 1] * inv); w.y = pk2(nt[4 * g4 + 2] * inv, nt[4 * g4 + 3] * inv); *(u32x2*)(op + 8 * g4) = w; }
        }
        CH_BARRIER();
        {
            int lane_ = lane; asm volatile("" : "+v"(lane_)); const int r = lane_ & 31, h = lane_ >> 5;
            const int a = wv >> 1, c0 = 2 * (wv & 1); const bool own_n = (wv & 1) == 0;
#pragma unroll
            for (int q = 0; q < 16; ++q) { ct0[q] *= decay; ct1[q] *= decay; ct2[q] *= decay; }
            const int ksw = (((32 * a + r) >> 3) & 7) << 4, vs0 = (((32 * c0 + r) >> 3) & 7) << 4, vs1 = (((32 * (c0 + 1) + r) >> 3) & 7) << 4;
#pragma unroll
            for (int ss = 0; ss < 4; ++ss) {
                const bf16x8 ka = *(const LAS bf16x8*)(L + KTS + (32 * a + r) * 144 + ((32 * ss + 16 * h) ^ ksw));
                const bf16x8 v0 = *(const LAS bf16x8*)(L + VTS + (32 * c0 + r) * 144 + ((32 * ss + 16 * h) ^ vs0)), v1 = *(const LAS bf16x8*)(L + VTS + (32 * (c0 + 1) + r) * 144 + ((32 * ss + 16 * h) ^ vs1));
                ct0 = mfma32(ka, v0, ct0); ct1 = mfma32(ka, v1, ct1);
                if (own_n) { const bf16x8 v2 = *(const LAS bf16x8*)(L + VTS + (128 + r) * 144 + 32 * ss + 16 * h); ct2 = mfma32(ka, v2, ct2); }
            }
#pragma unroll
            for (int g4 = 0; g4 < 4; ++g4) {
                u32x2 w; w.x = pk2(ct0[4 * g4], ct0[4 * g4 + 1]); w.y = pk2(ct0[4 * g4 + 2], ct0[4 * g4 + 3]); *(LAS u32x2*)(L + CTS + (32 * c0 + r) * 272 + (32 * a + 8 * g4 + 4 * h) * 2) = w;
                w.x = pk2(ct1[4 * g4], ct1[4 * g4 + 1]); w.y = pk2(ct1[4 * g4 + 2], ct1[4 * g4 + 3]); *(LAS u32x2*)(L + CTS + (32 * (c0 + 1) + r) * 272 + (32 * a + 8 * g4 + 4 * h) * 2) = w;
                if (own_n) { w.x = pk2(ct2[4 * g4], ct2[4 * g4 + 1]); w.y = pk2(ct2[4 * g4 + 2], ct2[4 * g4 + 3]); *(LAS u32x2*)(L + CTS + (128 + r) * 272 + (32 * a + 8 * g4 + 4 * h) * 2) = w; }
            }
        }
        CH_BARRIER();
    }
#undef CHAIN_LOAD
#undef CH_BARRIER
}

DI void phase_mix(const Ctx& X, int l, int sp, const int qsel = 0, const int parts = 31) {
    unsigned* q = X.ctl + CW_QUEUE + 64 * ((l * 8 + sp + qsel) * 8);
    LAS int* slot = (LAS int*)(X.lds + MISC_OFF + 64);
    const int nbs = X.nbs;
    if (parts & 1) { const int n = nbs * 8; for (;;) { const int it = qpop(X.tid, q, slot); if (it >= n) break; chain_item(X, l, sp * nbs, it); } }
    if (parts & 2) { const int np = nbs * 2, nbig = np * 28, nsm = np * 8, n = nbig + nsm + (l == 0 ? nbs * 8 : 0);
        for (;;) { const int it = qpop(X.tid, q + 64, slot); if (it >= n) break;
            if (it < nbig) attn_global64(X, l, (it / 28) * 32 + it % 28);
            else if (it < nbig + nsm) { const int k = it - nbig; attn_item<0>(X, l, (k >> 3) * 64 + 56 + (k & 7), false); }
            else attn_item<0>(X, l, it - nbig - nsm, true); } }
    const int nd = (l == 0 && sp == 0) ? 120 : 0, lim0 = (l == 0) ? 64 : 160;
    const int ne = (X.nsplit == 2) ? (sp == 0 ? lim0 : 384 - lim0) : (sp == X.nsplit - 1 ? 384 : 0), eoff = (X.nsplit == 2 && sp == 1) ? lim0 : 0;
    const int nconv = nd + ne;
    bool conv = (parts & 16) && nconv > 0;
#define MIX_CONV_ONE() do { if (conv) { const int ic_ = qpop(X.tid, q + 320, slot); if (ic_ < nconv) { if (ic_ >= nd) { const int ie_ = eoff + ic_ - nd; convert_experts(X, l, ie_ * 16, ie_ * 16 + 16); } else convert_dense(X, 1152 + ic_ * 16, 1152 + ic_ * 16 + 16); } else conv = false; } } while (0)
#define MIX_SHORT_LOOP(TY, qoff) do { const int nl = nbs * 128, n = nl + (l == 0 ? nbs * 8 : 0); int it = qpop(X.tid, q + (qoff), slot); \
        while (it < n) { int nraw = 0; if (X.tid == 0) nraw = (int)__hip_atomic_fetch_add(q + (qoff), 1u, __ATOMIC_RELAXED, __HIP_MEMORY_SCOPE_AGENT); \
            attn_item<TY>(X, l, it < nl ? it : it - nl, it >= nl); MIX_CONV_ONE(); \
            __syncthreads(); if (X.tid == 0) *slot = nraw; __syncthreads(); it = __builtin_amdgcn_readfirstlane(*slot); } } while (0)
    if (parts & 4) MIX_SHORT_LOOP(2, 128);
    if (parts & 8) MIX_SHORT_LOOP(1, 192);
#undef MIX_SHORT_LOOP
    while (conv) MIX_CONV_ONE();
#undef MIX_CONV_ONE
    __syncthreads();
}

DI void phase_inp(const Ctx& X, int l, int sp) {
    pg8::Gemm8 g{X.ws + OFF_h8in + (size_t)sp * X.rs * D, X.ws + OFF_win8 + (size_t)l * NPROJ * D, 1024, 1024, 1024, 0x7C7C7C7C, 0x7C7C7C7C};
    TileSched S{X.rs / 256, NPROJ / 256, X.G, X.bid, 0};
    EpiProj E{(bf16_t*)(X.ws + uo_projA(X.rs)), (bf16_t*)(X.ws + uo_projG(X.rs)), (bf16_t*)(X.ws + OFF_halo)};
    pg8::gemm_phase8(X.lds, X.tid, g, S, E);
}
DI void phase_mrg(const Ctx& X, int l, int sp) {
    pg8::Gemm8 g{X.ws + uo_bcat(X.rs), X.ws + OFF_wbr + (size_t)l * 1024 * 2048, 2048, 2048, 2048, 0x7C7C7C7C, 0x7C7C7C7C};
    float* PP = (float*)(X.ws + uo_projA(X.rs));
    EpiMerge E{(const bf16_t*)(X.ws + uo_projG(X.rs)), (bf16_t*)(X.ws + OFF_h), sp * X.rs, PP};
    if (l != 0) { TileSched S{X.nbs * 16, 4, X.G, X.bid, 1}; pg8::gemm_phase8(X.lds, X.tid, g, S, E); return; }
    MrgSched0 S{X.nbs, X.G, X.bid};
    pg8::gemm_phase8(X.lds, X.tid, g, S, E);
    unsigned* cnt = X.ctl + CW_QUEUE + 64 * ((l * 8 + sp) * 8 + 6);
    LAS int* slot = (LAS int*)(X.lds + MISC_OFF + 64);
    const int nfull = X.nbs * 64, npart = X.nbs * 16;
    for (int i = 0;; ++i) {
        const int L = i * X.G + X.bid; if (L >= nfull + npart) break; if (L < nfull) continue;
        const int c4 = (L - nfull) >> 2;
        __threadfence(); __syncthreads();
        if (X.tid == 0) *slot = (int)__hip_atomic_fetch_add(cnt + c4, 1u, __ATOMIC_ACQ_REL, __HIP_MEMORY_SCOPE_AGENT);
        __syncthreads();
        const int old = __builtin_amdgcn_readfirstlane(*slot);
        if (old == 3) {
            __threadfence();
            const int wid = X.wv, lane = X.lane, wr = wid >> 2, wc = wid & 3, fr = lane & 15, fq = lane >> 4, pm = (c4 >> 2) * 17, pn = c4 & 3;
            const float* pp = PP + (size_t)(c4 * 4) * 65536 + wid * 512 + lane * 8;
#pragma unroll 1
            for (int am = 0; am < 8; ++am) {
                const int row = pm * 256 + (am >> 2) * 128 + wr * 64 + (am & 3) * 16 + fr; unsigned char* yp = (unsigned char*)E.H + (size_t)(sp * X.rs + row) * D + pn * 256 + wc * 32 + 4 * fq;
#pragma unroll
                for (int bj = 0; bj < 2; ++bj) {
                    f32x4 s0 = {0.f, 0.f, 0.f, 0.f}, s1 = {0.f, 0.f, 0.f, 0.f};
#pragma unroll
                    for (int br = 0; br < 4; ++br) { const float* q = pp + (size_t)br * 65536 + (am * 2 + bj) * 4096; s0 += __builtin_nontemporal_load((const f32x4*)q); s1 += __builtin_nontemporal_load((const f32x4*)(q + 4)); }
                    *(unsigned*)(yp + bj * 128) = pk_fp8x4(s0[0], s0[1], s0[2], s0[3]); *(unsigned*)(yp + bj * 128 + 16) = pk_fp8x4(s1[0], s1[1], s1[2], s1[3]);
                }
            }
        }
    }
    __syncthreads();
}
DI void phase_out(const Ctx& X, int l) {
    pg8::Gemm8 g{X.ws + OFF_h, X.ws + OFF_wout + (size_t)l * 1024 * 1024, 1024, 1024, 1024, 0x7C7C7C7C, 0x7C7C7C7C};
    TileSched S{l == 0 ? NRT : NB * 16, 4, X.G, X.bid, l == 0 ? 0 : 1};
    EpiOut E{X.kp->in[I_X], X.kp->in[I_CTX], X.out, (float*)(X.ws + OFF_xc), (const float*)(X.ws + OFF_modv) + (size_t)l * 9 * 6144, l};
    pg8::gemm_phase8(X.lds, X.tid, g, S, E);
}
DI void phase_eup(const Ctx& X, int l, int vcu) {
#if N_LAUNCH_PER_STEP
    build_expert_tables(X, l);
#endif
    pg8::Gemm8 g{X.ws + OFF_h8, X.ws + OFF_wgu, 1024, 1024, 1024, 0x7C7C7C7C, 0x7C7C7C7C};
    ExpSchedG S{(const int*)(X.ws + OFF_xs), (const LAS int*)(X.lds + MISC_OFF + 4352), __builtin_amdgcn_readfirstlane(((const LAS int*)(X.lds + MISC_OFF + 4096))[33]), X.G, vcu};
    EpiUp E{X.ws + OFF_hmid};
    pg8::gemm_phase8(X.lds, X.tid, g, S, E);
}
DI void phase_edn(const Ctx& X, int l, int vcu) {
#if N_LAUNCH_PER_STEP
    build_expert_tables(X, l);
#endif
    pg8::Gemm8 g{X.ws + OFF_hmid, X.ws + OFF_wdn, 512, 512, 512, 0x7C7C7C7C, 0x7C7C7C7C};
    ExpSched S{(const LAS int*)(X.lds + MISC_OFF + 4352), __builtin_amdgcn_readfirstlane(((const LAS int*)(X.lds + MISC_OFF + 4096))[33]), X.G, vcu};
    EpiDown E{X.ws + OFF_ys};
    pg8::gemm_phase8(X.lds, X.tid, g, S, E);
}

DI int lane_id() { int x; asm volatile("v_mbcnt_lo_u32_b32 %0, -1, 0\n\tv_mbcnt_hi_u32_b32 %0, -1, %0" : "=v"(x)); return x; }
DI Ctx fresh_ctx(LAS unsigned char* lds, const int wvid) {
    KPtr kp = (KPtr)__builtin_amdgcn_kernarg_segment_ptr(); asm volatile("" : "+s"(kp));
    Ctx X; X.kp = kp; X.out = kp->out; X.ws = kp->ws; X.nsplit = kp->nsplit; X.lds = lds;
    { int t = wvid * 64 + lane_id(); asm volatile("" : "+v"(t)); X.tid = t; } X.lane = X.tid & 63; X.wv = __builtin_amdgcn_readfirstlane(X.tid >> 6);
    X.G = gridDim.x; X.bid = blockIdx.x; X.rs = T >> kp->lsplit; X.nbs = NB >> kp->lsplit; X.ctl = (unsigned*)(kp->ws + OFF_ctl);
    return X;
}
DI XcdBarrier fresh_bar(LAS unsigned char* lds) {
    KPtr kp = (KPtr)__builtin_amdgcn_kernarg_segment_ptr(); asm volatile("" : "+s"(kp));
    XcdBarrier b; b.bar = (unsigned*)(kp->ws + OFF_ctl); b.x = xb_xcc_id(); b.st = (volatile LAS unsigned*)(lds + MISC_OFF); return b;
}
#ifndef PHASE_MASK
#define PHASE_MASK 0xFFFF
#endif
__global__ void __launch_bounds__(NTHR, 2) fwd(Params p) {
    extern __shared__ __attribute__((aligned(16))) unsigned char smem[];
    LAS unsigned char* lds = (LAS unsigned char*)smem;
    if (threadIdx.x < 16) ((LAS unsigned*)(lds + MISC_OFF))[threadIdx.x] = 0u;
    __syncthreads();
    const int lo = p.step_lo, hi = p.step_hi;
    if (hi - lo > 1) (void)xcd_barrier_post((unsigned*)(p.ws + OFF_ctl), (volatile LAS unsigned*)(lds + MISC_OFF));
    const int wvid = __builtin_amdgcn_readfirstlane((int)threadIdx.x >> 6);
    int step = 0, l0 = 0, sp0 = 0;
#define STEP(k, body) do { if (step >= lo && step < hi) { if (PHASE_MASK & (1 << (k))) { const Ctx X = fresh_ctx(lds, wvid); int l = l0, sp = sp0; asm volatile("; PHASE_BEGIN " #k : "+s"(l), "+s"(sp)); (void)l; (void)sp; \
        const int vcu = (X.G % 8 == 0) ? (X.bid % 8) * (X.G / 8) + X.bid / 8 : X.bid; (void)vcu; body; asm volatile("; PHASE_END " #k); } if (step + 1 < hi) xcd_barrier(fresh_bar(lds), wvid * 64 + lane_id()); } ++step; } while (0)
#define STEPX(k, body) do { --step; if (step >= lo && step < hi) { { const Ctx X = fresh_ctx(lds, wvid); int l = l0, sp = sp0; asm volatile("; PHASEX_BEGIN " #k : "+s"(l), "+s"(sp)); (void)l; (void)sp; \
        const int vcu = (X.G % 8 == 0) ? (X.bid % 8) * (X.G / 8) + X.bid / 8 : X.bid; (void)vcu; body; } if (step + 1 < hi) xcd_barrier(fresh_bar(lds), wvid * 64 + lane_id()); } ++step; } while (0)
    STEP(0, phase_pro(X));
#if defined(REPEAT_CONV)
    STEPX(0, phase_pro(X));
#endif
    for (l0 = 0; l0 < 2; ++l0) {
        sp0 = 0;
        STEP(1, phase_pre(X, l));
#if defined(REPEAT_SMALL)
        STEPX(1, if (l == 0) phase_pre(X, l));
#endif
        for (sp0 = 0; sp0 < p.nsplit; ++sp0) {
            STEP(2, phase_inp(X, l, sp));
#if defined(REPEAT_INP)
            STEPX(2, phase_inp(X, l, sp));
#endif
            STEP(3, phase_elt(X, l));
            STEP(4, phase_mix(X, l, sp));
#if defined(REPEAT_MIXALL)
            STEPX(4, phase_mix(X, l, sp, 4, REPEAT_MIXALL));
#endif

            STEP(5, phase_cmb(X, l));
#if defined(REPEAT_SMALL)
            STEPX(5, phase_cmb(X, l));
#endif
            STEP(6, phase_mrg(X, l, sp));
#if defined(REPEAT_GEMMS) || defined(REPEAT_MRG)
            STEPX(6, phase_mrg(X, l, sp));
#endif
        }
        sp0 = 0;
        STEP(7, phase_out(X, l));
#if defined(REPEAT_OUT0)
        STEPX(7, if (l == 0) phase_out(X, l));
#endif
        STEP(8, phase_rte(X, l));

        STEP(9, phase_gat(X, l));
        STEP(10, phase_eup(X, l, vcu));
#if defined(REPEAT_GEMMS)
        STEPX(10, phase_eup(X, l, vcu));
#endif
        STEP(11, phase_edn(X, l, vcu));
#if defined(REPEAT_GEMMS)
        STEPX(11, phase_edn(X, l, vcu));
#endif
    }
    STEP(12, phase_fin(X));
#undef STEP
}

extern "C" void kernel_launch(void* const* d_in, const int* in_sizes, int n_in, void* d_out, int out_size, void* d_ws, size_t ws_size, hipStream_t stream) {
    static int grid = 0, nsplit = 0;
    if (grid == 0) {
        if (n_in != 25 || out_size != NB * SEQ * D) { fprintf(stderr, "kernel_launch: unexpected shapes (n_in %d, out %d)\n", n_in, out_size); grid = -1; return; }
        nsplit = 2; if (ws_need(2) > ws_size) nsplit = 4; if (ws_need(nsplit) > ws_size) nsplit = 8;
        if (ws_need(nsplit) > ws_size) { fprintf(stderr, "kernel_launch: workspace too small: %zu < %zu\n", ws_size, ws_need(nsplit)); grid = -1; return; }
        int dev = 0, cus = 0, per_cu = 0;
        if (hipGetDevice(&dev) != hipSuccess || hipDeviceGetAttribute(&cus, hipDeviceAttributeMultiprocessorCount, dev) != hipSuccess) { grid = -1; return; }
        if (hipFuncSetAttribute((const void*)fwd, hipFuncAttributeMaxDynamicSharedMemorySize, LDS_BYTES) != hipSuccess) { fprintf(stderr, "kernel_launch: hipFuncSetAttribute failed\n"); grid = -1; return; }
        if (hipOccupancyMaxActiveBlocksPerMultiprocessor(&per_cu, (const void*)fwd, NTHR, LDS_BYTES) != hipSuccess || per_cu < 1) fprintf(stderr, "kernel_launch: occupancy query says %d\n", per_cu);
        (void)hipGetLastError();
        grid = cus;
        fprintf(stderr, "kernel_launch: grid %d nsplit %d ws %zu need %zu\n", grid, nsplit, ws_size, ws_need(nsplit));
    }
    if (grid < 0) return;
    if (hipMemsetAsync(d_ws, 0, 65536, stream) != hipSuccess) return;
    Params p{};
    for (int i = 0; i < 25; ++i) p.in[i] = (const float*)d_in[i];
    p.out = (float*)d_out; p.ws = (unsigned char*)d_ws; p.nsplit = nsplit; p.lsplit = nsplit == 2 ? 1 : nsplit == 4 ? 2 : 3;
    const int nsteps = 1 + 2 * (1 + 5 * nsplit + 5) + 1;
#if N_LAUNCH_PER_STEP
    for (int s = 0; s < nsteps; ++s) { p.step_lo = s; p.step_hi = s + 1; hipLaunchKernelGGL(fwd, dim3(grid), dim3(NTHR), LDS_BYTES, stream, p); }
#else
    p.step_lo = 0; p.step_hi = nsteps; hipLaunchKernelGGL(fwd, dim3(grid), dim3(NTHR), LDS_BYTES, stream, p);
#endif
}
```

```cpp
#include <hip/hip_runtime.h>
#include <stdint.h>
#include <stdio.h>

#define LAS __attribute__((address_space(3)))
#define DI __device__ __forceinline__
typedef unsigned short bf16_t;
typedef short bf16x8 __attribute__((ext_vector_type(8)));
typedef short s16x4 __attribute__((ext_vector_type(4)));
typedef float f32x4 __attribute__((ext_vector_type(4)));
typedef float f32x2 __attribute__((ext_vector_type(2)));
typedef float f32x16 __attribute__((ext_vector_type(16)));
typedef unsigned u32x4 __attribute__((ext_vector_type(4)));
typedef unsigned u32x2 __attribute__((ext_vector_type(2)));
typedef __bf16 bfx2 __attribute__((ext_vector_type(2)));

#ifndef N_LAUNCH_PER_STEP
#define N_LAUNCH_PER_STEP 0
#endif

constexpr int D = 1024, NB = 8, SEQ = 4096, CTX = 256, TPB = 4352, T = NB * TPB, NRT = T / 256;
constexpr int NPA = 5120, NPG = 4096, NPROJ = NPA + NPG, WIN_LD = 9232;
constexpr int C_MQ = 0, C_MK = 512, C_MV = 1024, C_MO = 1536, C_GQ = 2048, C_GK = 2560, C_GV = 2688, C_WQ = 2816, C_WK = 3328, C_WV = 3456, C_NQ = 3584, C_NK = 4096, C_NV = 4608;
constexpr int CAP = 77824, NE = 32;
constexpr float EPS = 1e-6f;
constexpr int NTHR = 512;
constexpr int LDS_BYTES = 147456;
constexpr int MISC_OFF = 131072;

DI float bf2f(bf16_t v) { return __uint_as_float(((unsigned)v) << 16); }
DI float bflo(unsigned u) { return __uint_as_float(u << 16); }
DI float bfhi(unsigned u) { return __uint_as_float(u & 0xffff0000u); }
DI unsigned pk2(float lo, float hi) { f32x2 v = {lo, hi}; return __builtin_bit_cast(unsigned, __builtin_convertvector(v, bfx2)); }
typedef _Float16 hfx2 __attribute__((ext_vector_type(2)));
DI unsigned pkh2(float lo, float hi) { f32x2 v = {lo, hi}; return __builtin_bit_cast(unsigned, __builtin_convertvector(v, hfx2)); }
DI f32x4 hf4(u32x2 w) { const hfx2 a = __builtin_bit_cast(hfx2, w.x), b = __builtin_bit_cast(hfx2, w.y); return (f32x4){(float)a[0], (float)a[1], (float)b[0], (float)b[1]}; }
DI unsigned pk_fp8x4(float a, float b, float c, float d) {
    a = fminf(fmaxf(a, -448.f), 448.f); b = fminf(fmaxf(b, -448.f), 448.f); c = fminf(fmaxf(c, -448.f), 448.f); d = fminf(fmaxf(d, -448.f), 448.f);
    int p = 0; p = __builtin_amdgcn_cvt_pk_fp8_f32(a, b, p, false); p = __builtin_amdgcn_cvt_pk_fp8_f32(c, d, p, true); return (unsigned)p;
}
DI unsigned pk_fp8x4_nc(float a, float b, float c, float d) { int p = 0; p = __builtin_amdgcn_cvt_pk_fp8_f32(a, b, p, false); p = __builtin_amdgcn_cvt_pk_fp8_f32(c, d, p, true); return (unsigned)p; }
DI bf16_t f2bf(float x) { return (bf16_t)(pk2(x, 0.f) & 0xffffu); }
DI float rcpf_(float x) { return __builtin_amdgcn_rcpf(x); }
DI float sigmoidf_(float x) { return rcpf_(1.f + __expf(-x)); }
DI float siluf_(float x) { return x * rcpf_(1.f + __expf(-x)); }
DI float dpp_add(float v, const int ctrl_sel) {
    const int x = __float_as_int(v);
    const int y = ctrl_sel == 0 ? __builtin_amdgcn_update_dpp(0, x, 0xB1, 0xF, 0xF, true) : ctrl_sel == 1 ? __builtin_amdgcn_update_dpp(0, x, 0x4E, 0xF, 0xF, true)
                : ctrl_sel == 2 ? __builtin_amdgcn_update_dpp(0, x, 0x141, 0xF, 0xF, true) : __builtin_amdgcn_update_dpp(0, x, 0x140, 0xF, 0xF, true);
    return v + __int_as_float(y);
}
DI float row16_sum(float v) { v = dpp_add(v, 0); v = dpp_add(v, 1); v = dpp_add(v, 2); v = dpp_add(v, 3); return v; }
DI float wave_sum(float v) {
    v = row16_sum(v); const int x = __float_as_int(v);
    return (__int_as_float(__builtin_amdgcn_readlane(x, 0)) + __int_as_float(__builtin_amdgcn_readlane(x, 16))) + (__int_as_float(__builtin_amdgcn_readlane(x, 32)) + __int_as_float(__builtin_amdgcn_readlane(x, 48)));
}
template <bool MAX> DI float wave_scan(float v) {
    const int id = __float_as_int(MAX ? -3.0e38f : 0.f);
#define WSC_STEP(ctrl, rmask) do { const float t_ = __int_as_float(__builtin_amdgcn_update_dpp(id, __float_as_int(v), ctrl, rmask, 0xF, false)); v = MAX ? fmaxf(v, t_) : v + t_; } while (0)
    WSC_STEP(0x111, 0xF); WSC_STEP(0x112, 0xF); WSC_STEP(0x114, 0xF); WSC_STEP(0x118, 0xF); WSC_STEP(0x142, 0xA); WSC_STEP(0x143, 0xC);
#undef WSC_STEP
    return v;
}
template <int O> DI float xlane_dpp(float v) {
    const int x = __float_as_int(v);
    if (O == 1) return __int_as_float(__builtin_amdgcn_update_dpp(0, x, 0xB1, 0xF, 0xF, true));
    if (O == 2) return __int_as_float(__builtin_amdgcn_update_dpp(0, x, 0x4E, 0xF, 0xF, true));
    const int t = __builtin_amdgcn_update_dpp(0, x, 0x141, 0xF, 0xF, true); return __int_as_float(__builtin_amdgcn_update_dpp(0, t, 0x1B, 0xF, 0xF, true));
}
DI float lane_bcast(float v, const int srclane) { return __int_as_float(__builtin_amdgcn_readlane(__float_as_int(v), srclane)); }
DI float sum_x32(float v) { auto rr = __builtin_amdgcn_permlane32_swap(__float_as_uint(v), __float_as_uint(v), false, false); return __uint_as_float(rr[0]) + __uint_as_float(rr[1]); }
DI f32x16 mfma32(bf16x8 a, bf16x8 b, f32x16 c) { return __builtin_amdgcn_mfma_f32_32x32x16_bf16(a, b, c, 0, 0, 0); }
DI bf16x8 pack8(float a0, float a1, float a2, float a3, float a4, float a5, float a6, float a7) {
    u32x4 p; p.x = pk2(a0, a1); p.y = pk2(a2, a3); p.z = pk2(a4, a5); p.w = pk2(a6, a7); return __builtin_bit_cast(bf16x8, p);
}
DI int crow(int reg, int h) { return (reg & 3) + 8 * (reg >> 2) + 4 * h; }

constexpr size_t al256(size_t x) { return (x + 255) & ~(size_t)255; }
constexpr size_t OFF_ctl = 0;
constexpr size_t OFF_modv = OFF_ctl + 65536;
constexpr size_t OFF_rope = OFF_modv + al256((size_t)2 * 9 * 6144 * 4);
constexpr size_t OFF_gI = OFF_rope + 8192;
constexpr size_t OFF_gF = OFF_gI + al256((size_t)2 * NB * 4 * TPB * 4);
constexpr size_t OFF_tokE = OFF_gF + al256((size_t)2 * NB * 4 * TPB * 4);
constexpr size_t OFF_tokS = OFF_tokE + al256((size_t)T * 2 * 4);
constexpr size_t OFF_tokW = OFF_tokS + al256((size_t)T * 2 * 4);
constexpr size_t OFF_halo = OFF_tokW + al256((size_t)T * 2 * 4);
constexpr size_t OFF_xsb = OFF_halo + al256((size_t)(T / 2 / 64) * 4 * 1024 * 2);
constexpr size_t OFF_wbr = OFF_xsb + (size_t)T * D * 2;
constexpr size_t OFF_wout = OFF_wbr + (size_t)2 * 1024 * 2048 * 2;
constexpr size_t OFF_wgu = OFF_wout + (size_t)2 * 1024 * 1024 * 2;
constexpr size_t OFF_wdn = OFF_wgu + (size_t)NE * 1024 * 1024;
constexpr size_t OFF_win8 = OFF_wdn + (size_t)NE * 1024 * 512;
constexpr size_t OFF_h = OFF_win8 + (size_t)2 * NPROJ * D;
constexpr size_t OFF_h8in = OFF_h + (size_t)T * D;
constexpr size_t OFF_u = OFF_h8in + (size_t)T * D;
constexpr size_t OFF_xs = OFF_u;
constexpr size_t OFF_hmid = OFF_xs + (size_t)CAP * 1024;
constexpr size_t OFF_ys = OFF_hmid + (size_t)CAP * 512;
constexpr size_t OFF_h8 = OFF_ys + (size_t)CAP * 1024 * 2;
constexpr size_t OFF_moe_end = OFF_h8 + (size_t)T * 1024;
__host__ __device__ inline size_t uo_projA(size_t rs) { return OFF_u; }
__host__ __device__ inline size_t uo_projG(size_t rs) { return OFF_u + rs * NPA * 2; }
__host__ __device__ inline size_t uo_bcat(size_t rs) { return OFF_u + rs * (NPA + NPG) * 2; }
__host__ __device__ inline size_t uo_hpart(size_t rs) { return OFF_u + rs * (NPA + NPG + 2048) * 2; }
__host__ __device__ inline size_t uo_end(size_t rs) { return OFF_u + rs * (NPA + NPG + 2048 + 1024) * 2; }
inline size_t ws_need(int nsplit) { const size_t a = uo_end((size_t)T / nsplit); return a > OFF_moe_end ? a : OFF_moe_end; }
#define XB_TMO      128
#define XB_XCNT(j)  (256  + 64 * (j))
#define XB_XSUB(j)  (1280 + 64 * (j))
#define XB_XGEN(j)  (2304 + 64 * (j))
#define XB_TOP      3328
#define XB_TOPGEN   3392
#define XCD_BAR_WORDS 3456
#define XB_SPIN_CAP (1u << 22)
constexpr int CW_QUEUE = 4096;
constexpr int CW_CNT = 12288;

DI unsigned xb_ld(unsigned* p)              { return __hip_atomic_load(p, __ATOMIC_RELAXED, __HIP_MEMORY_SCOPE_AGENT); }
DI unsigned xb_add(unsigned* p, unsigned v) { return __hip_atomic_fetch_add(p, v, __ATOMIC_RELAXED, __HIP_MEMORY_SCOPE_AGENT); }
DI unsigned xb_xcc_id() { return (unsigned)__builtin_amdgcn_s_getreg((3 << 11) | 20) & 0xFu; }
#define XB_SPIN(cond, bar) do { unsigned _sp = 0; while (cond) { __builtin_amdgcn_s_sleep(1); \
    if ((++_sp & 255u) == 0u) { if (xb_ld(&(bar)[XB_TMO])) break; if (_sp > XB_SPIN_CAP) { atomicAdd(&(bar)[XB_TMO], 1u); break; } } } } while (0)
struct XcdBarrier { unsigned* bar; unsigned x; volatile LAS unsigned* st; };
DI XcdBarrier xcd_barrier_post(unsigned* bar, volatile LAS unsigned* st) {
    XcdBarrier b; b.bar = bar; b.x = xb_xcc_id(); b.st = st;
    if (threadIdx.x == 0) (void)xb_add(&bar[XB_XCNT(b.x)], 1u);
    return b;
}
DI void xcd_barrier_complete(unsigned* bar, unsigned x, unsigned& nloc, unsigned& nx) {
    const unsigned G = gridDim.x * gridDim.y * gridDim.z;
    unsigned sum, cnt, mine, sp = 0u;
    for (;;) {
        sum = 0u; cnt = 0u; mine = 0u;
#pragma unroll
        for (unsigned j = 0; j < 16; ++j) { const unsigned c = xb_ld(&bar[XB_XCNT(j)]); sum += c; cnt += (c > 0u) ? 1u : 0u; mine = (j == x) ? c : mine; }
        if (sum == G) break;
        __builtin_amdgcn_s_sleep(1);
        if ((++sp & 255u) == 0u) { if (xb_ld(&bar[XB_TMO])) break; if (sp > XB_SPIN_CAP) { atomicAdd(&bar[XB_TMO], 1u); break; } }
    }
    nloc = mine > 0u ? mine : 1u; nx = cnt > 0u ? cnt : 1u;
}
DI void xcd_barrier(const XcdBarrier& b, const int tid) {
    asm volatile("s_waitcnt vmcnt(0)" ::: "memory");
    __syncthreads();
    if (tid == 0) {
        unsigned* bar = b.bar;
        __builtin_amdgcn_s_waitcnt(0);
        unsigned nloc = b.st[0], nx = b.st[1];
        if (nloc == 0u) { xcd_barrier_complete(bar, b.x, nloc, nx); b.st[0] = nloc; b.st[1] = nx; }
        const unsigned old = xb_add(&bar[XB_XSUB(b.x)], 1u);
        const unsigned gen = old / nloc;
        if (old + 1u == (gen + 1u) * nloc) {
            __builtin_amdgcn_fence(__ATOMIC_RELEASE, "agent");
            asm volatile("s_waitcnt vmcnt(0)" ::: "memory");
            const unsigned og = xb_add(&bar[XB_TOP], 1u);
            const unsigned tg = og / nx;
            if (og + 1u == (tg + 1u) * nx) xb_add(&bar[XB_TOPGEN], 1u);
            else XB_SPIN(xb_ld(&bar[XB_TOPGEN]) == tg, bar);
            __builtin_amdgcn_fence(__ATOMIC_ACQUIRE, "agent");
            xb_add(&bar[XB_XGEN(b.x)], 1u);
            asm volatile("s_waitcnt vmcnt(0)" ::: "memory");
        } else {
            XB_SPIN(xb_ld(&bar[XB_XGEN(b.x)]) == gen, bar);
            __builtin_amdgcn_fence(__ATOMIC_ACQUIRE, "agent");
            asm volatile("s_waitcnt vmcnt(0)" ::: "memory");
        }
    }
    __syncthreads();
}

struct Params { const float* in[25]; float* out; unsigned char* ws; int nsplit, lsplit, step_lo, step_hi; };
typedef __attribute__((address_space(4))) Params ParamsK; typedef const ParamsK* KPtr;
struct Ctx {
    KPtr kp; float* out; unsigned char* ws;
    LAS unsigned char* lds; int tid, lane, wv, G, bid, nsplit, rs  , nbs  ;
    unsigned* ctl;
};
enum { I_X = 0, I_C, I_CTX, I_CCTX, I_WMOD, I_BMOD, I_N1G, I_N2G, I_WIN, I_CONVW, I_CONVB, I_GATEB, I_MNORMG, I_QNORM, I_KNORM, I_SINK, I_RELB, I_WBR, I_WOUT, I_WR, I_RB, I_EG, I_EU, I_ED, I_FING };

namespace pg8 {
constexpr int BM = 256, BK = 64, HALF = 128, HTB = HALF * BK * 2, STAGE_BYTES = 8 * HTB, NXCD = 8, WGM = 8;
DI int lds_byte(int r, int c) { const int st = (r >> 4) * 2 + (c >> 5), rr = r & 15, cc = c & 31, ob = rr * 64 + cc * 2; return st * 1024 + (ob ^ (((ob >> 9) & 1) << 5)); }
DI void stage_rc(int b, int& R, int& C) { const int st = b / 1024, sb = b % 1024, swz = sb ^ (((sb >> 9) & 1) << 5); R = (st >> 1) * 16 + swz / 64; C = (st & 1) * 32 + (swz % 64) / 2; }
DI int perm32(int rho) { const int n = rho >> 4, i = rho & 15; return 8 * (i >> 2) + 4 * n + (i & 3); }
struct Unit { int pm, pn, ko, aux, kt; };
struct Gemm { const bf16_t* A; const bf16_t* Bt; int K, lda, ldb; };
DI void tile_order(int L, int nM, int nN, int& pm, int& pn) {
    const int nwg = nM * nN; int wgid = L;
    { const int q = nwg / NXCD, r = nwg % NXCD, xcd = wgid % NXCD, off = wgid / NXCD; wgid = (xcd < r ? xcd * (q + 1) : r * (q + 1) + (xcd - r) * q) + off; }
    const int nig = WGM * nN, gid = wgid / nig, fm = gid * WGM, gsz = (nM - fm) < WGM ? (nM - fm) : WGM;
    pm = fm + ((wgid % nig) % gsz); pn = (wgid % nig) / gsz;
}
template <class Epi, class Sched>
DI void gemm_phase(LAS unsigned char* lds, const int tid, const Gemm g, const Sched& S, const Epi& E) {
    const int wid = __builtin_amdgcn_readfirstlane(tid >> 6), lane = tid & 63, wr = wid >> 2, wc = wid & 3, fr = lane & 15, fq = lane >> 4;
    int K = g.K; asm volatile("" : "+s"(K)); const int nt = K / BK;
    unsigned voffA[2], voffB[2];
#pragma unroll
    for (int i = 0; i < 2; ++i) { int R, C; stage_rc(tid * 16 + i * 8192, R, C); const int Rb = Epi::PERM ? ((R & ~31) + perm32(R & 31)) : R;
        voffA[i] = (unsigned)(R * g.lda + C) * 2u; voffB[i] = (unsigned)(Rb * g.ldb + C) * 2u; }
    const size_t kstep = (size_t)(BK * 2);
    const size_t hstepA = (size_t)HALF * g.lda * 2, hstepB = (size_t)HALF * g.ldb * 2;
    const size_t tstepA = 2 * hstepA, tstepB = 2 * hstepB;
    const unsigned ldsw = (unsigned)wid * 1024u;
    const int aoff = lds_byte(wr * 64 + fr, fq * 8), boff = lds_byte(wc * 32 + fr, fq * 8);
#define PG8_SA(b, h) (((b) * 2 + (h)) * HTB)
#define PG8_SB(b, h) ((4 + (b) * 2 + (h)) * HTB)
#define PG8_STAGE(bufoff, gbase, voff) do { _Pragma("unroll") for (int _i = 0; _i < 2; ++_i) \
        __builtin_amdgcn_global_load_lds((const unsigned*)((const char*)(gbase) + (voff)[_i]), (LAS unsigned*)(lds + (bufoff) + ldsw + _i * 8192), 16, 0, 0); } while (0)
#define PG8_LDA(dst, b, h) do { _Pragma("unroll") for (int m = 0; m < 4; ++m) _Pragma("unroll") for (int k = 0; k < 2; ++k) dst[m][k] = *(const LAS bf16x8*)(lds + PG8_SA(b, h) + aoff + m * 2048 + k * 1024); } while (0)
#define PG8_LDB(dst, b, h) do { _Pragma("unroll") for (int n = 0; n < 2; ++n) _Pragma("unroll") for (int k = 0; k < 2; ++k) dst[n][k] = *(const LAS bf16x8*)(lds + PG8_SB(b, h) + boff + n * 2048 + k * 1024); } while (0)
#define PG8_MMA(ai, bj, At, Bt) do { __builtin_amdgcn_s_setprio(1); _Pragma("unroll") for (int m = 0; m < 4; ++m) _Pragma("unroll") for (int n = 0; n < 2; ++n) _Pragma("unroll") for (int k = 0; k < 2; ++k) \
        acc[ai][bj][m][n] = __builtin_amdgcn_mfma_f32_16x16x32_bf16(Bt[n][k], At[m][k], acc[ai][bj][m][n], 0, 0, 0); __builtin_amdgcn_s_setprio(0); } while (0)
#define PG8_WAIT_V(n) asm volatile("s_waitcnt vmcnt(" #n ")" ::: "memory")
#define PG8_WAIT_L(n) asm volatile("s_waitcnt lgkmcnt(" #n ")" ::: "memory")
#define PG8_BAR __builtin_amdgcn_s_barrier()
#define PG8_SCHED __builtin_amdgcn_sched_barrier(0)
    Unit cur, nxt; int ui = 0;
    if (!S.next(0, cur)) return;
    f32x4 acc[2][2][4][2];
#pragma unroll
    for (int a = 0; a < 2; ++a)
#pragma unroll
        for (int b = 0; b < 2; ++b)
#pragma unroll
            for (int m = 0; m < 4; ++m)
#pragma unroll
                for (int n = 0; n < 2; ++n) acc[a][b][m][n] = (f32x4){0.f, 0.f, 0.f, 0.f};
    bf16x8 At[4][2], B0[2][2], B1[2][2];
    const char* cA = (const char*)g.A + (size_t)cur.pm * tstepA + (size_t)cur.ko * 2; const char* cB = (const char*)g.Bt + (size_t)cur.pn * tstepB + (size_t)cur.ko * 2;
    PG8_STAGE(PG8_SB(0, 0), cB, voffB); PG8_STAGE(PG8_SA(0, 0), cA, voffA); PG8_STAGE(PG8_SB(0, 1), cB + hstepB, voffB); PG8_STAGE(PG8_SA(0, 1), cA + hstepA, voffA);
    if (wr == 1) PG8_BAR;
    PG8_WAIT_V(4); PG8_BAR;
    PG8_STAGE(PG8_SB(1, 0), cB + kstep, voffB); PG8_STAGE(PG8_SA(1, 0), cA + kstep, voffA); PG8_STAGE(PG8_SB(1, 1), cB + hstepB + kstep, voffB);
    PG8_WAIT_V(6); PG8_BAR;
    for (;;) {
        const bool has_next = S.next(ui + 1, nxt);
        const char* nA = has_next ? (const char*)g.A + (size_t)nxt.pm * tstepA + (size_t)nxt.ko * 2 : cA; const char* nB = has_next ? (const char*)g.Bt + (size_t)nxt.pn * tstepB + (size_t)nxt.ko * 2 : cB;
#pragma unroll 1
        for (int t = 0; t < nt; t += 2) {
            if constexpr (Epi::HOOK_T > 0) { if (t > 0 && (t & (Epi::HOOK_T - 1)) == 0) E.mid(acc, cur, t / Epi::HOOK_T, wr, wc, fr, fq); }
            const bool last = (t == nt - 2);
            const char* a1 = cA + (size_t)(t + 1) * kstep;
            const char* a2 = last ? nA : cA + (size_t)(t + 2) * kstep; const char* b2 = last ? nB : cB + (size_t)(t + 2) * kstep;
            const char* a3 = a2 + kstep; const char* b3 = b2 + kstep;
            PG8_LDB(B0, 0, 0); PG8_SCHED; PG8_LDA(At, 0, 0); PG8_STAGE(PG8_SA(1, 1), a1 + hstepA, voffA);
            PG8_WAIT_L(8); PG8_BAR; PG8_WAIT_L(0); PG8_MMA(0, 0, At, B0); PG8_BAR; PG8_SCHED;
            PG8_LDB(B1, 0, 1); PG8_STAGE(PG8_SB(0, 0), b2, voffB);
            PG8_BAR; PG8_WAIT_L(0); PG8_MMA(0, 1, At, B1); PG8_BAR;
            PG8_LDA(At, 0, 1); PG8_STAGE(PG8_SA(0, 0), a2, voffA);
            PG8_BAR; PG8_WAIT_L(0); PG8_MMA(1, 0, At, B0); PG8_BAR; PG8_SCHED;
            PG8_STAGE(PG8_SB(0, 1), b2 + hstepB, voffB);
            PG8_WAIT_V(6); PG8_BAR; PG8_MMA(1, 1, At, B1); PG8_BAR;
            PG8_LDB(B0, 1, 0); PG8_SCHED; PG8_LDA(At, 1, 0); PG8_STAGE(PG8_SA(0, 1), a2 + hstepA, voffA);
            PG8_WAIT_L(8); PG8_BAR; PG8_WAIT_L(0); PG8_MMA(0, 0, At, B0); PG8_BAR; PG8_SCHED;
            PG8_LDB(B1, 1, 1); PG8_STAGE(PG8_SB(1, 0), b3, voffB);
            PG8_BAR; PG8_WAIT_L(0); PG8_MMA(0, 1, At, B1); PG8_BAR;
            PG8_LDA(At, 1, 1); PG8_STAGE(PG8_SA(1, 0), a3, voffA);
            PG8_BAR; PG8_WAIT_L(0); PG8_MMA(1, 0, At, B0); PG8_BAR; PG8_SCHED;
            PG8_STAGE(PG8_SB(1, 1), b3 + hstepB, voffB);
            PG8_WAIT_V(6); PG8_BAR; PG8_MMA(1, 1, At, B1); PG8_BAR;
        }
        E(acc, cur, wr, wc, fr, fq);
        if (!has_next) break;
#pragma unroll
        for (int a = 0; a < 2; ++a)
#pragma unroll
            for (int b = 0; b < 2; ++b)
#pragma unroll
                for (int m = 0; m < 4; ++m)
#pragma unroll
                    for (int n = 0; n < 2; ++n) acc[a][b][m][n] = (f32x4){0.f, 0.f, 0.f, 0.f};
        cur = nxt; cA = nA; cB = nB; ++ui;
    }
    PG8_WAIT_V(0);
    if (wr == 0) PG8_BAR;
    PG8_BAR;
#undef PG8_SA
#undef PG8_SB
#undef PG8_STAGE
#undef PG8_LDA
#undef PG8_LDB
#undef PG8_MMA
#undef PG8_WAIT_V
#undef PG8_WAIT_L
#undef PG8_BAR
#undef PG8_SCHED
}
typedef int v8i32 __attribute__((ext_vector_type(8)));
typedef int i32x4 __attribute__((ext_vector_type(4)));
struct Gemm8 { const unsigned char* A; const unsigned char* Bt; int K, lda, ldb; int scale_a, scale_b; };
template <class Epi, class Sched>
DI void gemm_phase8(LAS unsigned char* lds, const int tid, const Gemm8 g, const Sched& S, const Epi& E) {
    const int wid = __builtin_amdgcn_readfirstlane(tid >> 6), lane = tid & 63, wr = wid >> 2, wc = wid & 3, fr = lane & 15, fq = lane >> 4;
    int K = g.K; asm volatile("" : "+s"(K)); const int nt = K / 128;
    unsigned voffA[2], voffB[2];
#pragma unroll
    for (int i = 0; i < 2; ++i) { int R, C; stage_rc(tid * 16 + i * 8192, R, C); const int Rb = Epi::PERM ? ((R & ~31) + perm32(R & 31)) : R;
        voffA[i] = (unsigned)(R * g.lda + C * 2); voffB[i] = (unsigned)(Rb * g.ldb + C * 2); }
    const size_t kstep = (size_t)(BK * 2);
    const size_t hstepA = (size_t)HALF * g.lda, hstepB = (size_t)HALF * g.ldb;
    const size_t tstepA = 2 * hstepA, tstepB = 2 * hstepB;
    const unsigned ldsw = (unsigned)wid * 1024u;
    const int aoff = lds_byte(wr * 64 + fr, fq * 8), boff = lds_byte(wc * 32 + fr, fq * 8);
#define PG8_SA(b, h) (((b) * 2 + (h)) * HTB)
#define PG8_SB(b, h) ((4 + (b) * 2 + (h)) * HTB)
#define PG8_STAGE(bufoff, gbase, voff) do { _Pragma("unroll") for (int _i = 0; _i < 2; ++_i) \
        __builtin_amdgcn_global_load_lds((const unsigned*)((const char*)(gbase) + (voff)[_i]), (LAS unsigned*)(lds + (bufoff) + ldsw + _i * 8192), 16, 0, 0); } while (0)
#define PG8_LD32(p) __builtin_shufflevector(*(const LAS i32x4*)(p), *(const LAS i32x4*)((p) + 1024), 0, 1, 2, 3, 4, 5, 6, 7)
#define PG8_LDA(dst, b, h) do { _Pragma("unroll") for (int m = 0; m < 4; ++m) dst[m] = PG8_LD32(lds + PG8_SA(b, h) + aoff + m * 2048); } while (0)
#define PG8_LDB(dst, b, h) do { _Pragma("unroll") for (int n = 0; n < 2; ++n) dst[n] = PG8_LD32(lds + PG8_SB(b, h) + boff + n * 2048); } while (0)
#define PG8_MMA(ai, bj, At, Bt) do { __builtin_amdgcn_s_setprio(1); _Pragma("unroll") for (int m = 0; m < 4; ++m) _Pragma("unroll") for (int n = 0; n < 2; ++n) \
        asm volatile("v_mfma_scale_f32_16x16x128_f8f6f4 %0, %1, %2, %0, %3, %4 op_sel_hi:[0,0,0]" : "+v"(acc[ai][bj][m][n]) : "v"(Bt[n]), "v"(At[m]), "v"(sc_b), "v"(sc_a)); __builtin_amdgcn_s_setprio(0); } while (0)
#define PG8_WAIT_V(n) asm volatile("s_waitcnt vmcnt(" #n ")" ::: "memory")
#define PG8_WAIT_L(n) asm volatile("s_waitcnt lgkmcnt(" #n ")" ::: "memory")
#define PG8_BAR __builtin_amdgcn_s_barrier()
#define PG8_SCHED __builtin_amdgcn_sched_barrier(0)
    Unit cur, nxt; int ui = 0;
    if (!S.next(0, cur)) return;
    constexpr bool GA = Sched::GATHER;
    unsigned vgC[2][2] = {{0u, 0u}, {0u, 0u}}, vgN[2][2] = {{0u, 0u}, {0u, 0u}};
#define PG8_GOFFS(u_, vg_) do { _Pragma("unroll") for (int _h = 0; _h < 2; ++_h) _Pragma("unroll") for (int _i = 0; _i < 2; ++_i) { int R_, C_; stage_rc(tid * 16 + _i * 8192, R_, C_); \
        vg_[_h][_i] = (unsigned)S.row_of((u_).pm * 256 + _h * 128 + R_) * (unsigned)g.lda + (unsigned)(C_ * 2); } } while (0)
#define PG8_STAGE2(bufoff, gbase, v0_, v1_) do { \
        __builtin_amdgcn_global_load_lds((const unsigned*)((const char*)(gbase) + (v0_)), (LAS unsigned*)(lds + (bufoff) + ldsw), 16, 0, 0); \
        __builtin_amdgcn_global_load_lds((const unsigned*)((const char*)(gbase) + (v1_)), (LAS unsigned*)(lds + (bufoff) + ldsw + 8192), 16, 0, 0); } while (0)
    if constexpr (GA) PG8_GOFFS(cur, vgC);
    f32x4 acc[2][2][4][2];
#pragma unroll
    for (int a = 0; a < 2; ++a)
#pragma unroll
        for (int b = 0; b < 2; ++b)
#pragma unroll
            for (int m = 0; m < 4; ++m)
#pragma unroll
                for (int n = 0; n < 2; ++n) acc[a][b][m][n] = (f32x4){0.f, 0.f, 0.f, 0.f};
    v8i32 At[4], B0[2], B1[2];
    int sc_a = g.scale_a; asm volatile("" : "+v"(sc_a)); const int sc_b = sc_a;
    const char* cA = (const char*)g.A + (GA ? (size_t)0 : (size_t)cur.pm * tstepA) + (size_t)cur.ko; const char* cB = (const char*)g.Bt + (size_t)cur.pn * tstepB + (size_t)cur.ko;
    PG8_STAGE(PG8_SB(0, 0), cB, voffB);
    if constexpr (GA) PG8_STAGE2(PG8_SA(0, 0), cA, vgC[0][0], vgC[0][1]); else PG8_STAGE(PG8_SA(0, 0), cA, voffA);
    PG8_STAGE(PG8_SB(0, 1), cB + hstepB, voffB);
    if constexpr (GA) PG8_STAGE2(PG8_SA(0, 1), cA, vgC[1][0], vgC[1][1]); else PG8_STAGE(PG8_SA(0, 1), cA + hstepA, voffA);
    if (wr == 1) PG8_BAR;
    PG8_WAIT_V(4); PG8_BAR;
    PG8_STAGE(PG8_SB(1, 0), cB + kstep, voffB);
    if constexpr (GA) PG8_STAGE2(PG8_SA(1, 0), cA + kstep, vgC[0][0], vgC[0][1]); else PG8_STAGE(PG8_SA(1, 0), cA + kstep, voffA);
    PG8_STAGE(PG8_SB(1, 1), cB + hstepB + kstep, voffB);
    PG8_WAIT_V(6); PG8_BAR;
    for (;;) {
        const bool has_next = S.next(ui + 1, nxt);
        const char* nA = has_next ? (const char*)g.A + (GA ? (size_t)0 : (size_t)nxt.pm * tstepA) + (size_t)nxt.ko : cA; const char* nB = has_next ? (const char*)g.Bt + (size_t)nxt.pn * tstepB + (size_t)nxt.ko : cB;
        if constexpr (GA) { if (has_next) PG8_GOFFS(nxt, vgN); }
        const int ntu = cur.kt ? cur.kt : nt;
#pragma unroll 1
        for (int t = 0; t < ntu; t += 2) {
            if constexpr (Epi::HOOK_T > 0) { if (t > 0 && (t & (Epi::HOOK_T - 1)) == 0) { asm volatile("s_nop 15\n\ts_nop 15" ::: "memory"); E.mid(acc, cur, t / Epi::HOOK_T, wr, wc, fr, fq); asm volatile("s_nop 7" ::: "memory"); } }
            const bool last = (t == ntu - 2);
            const char* a1 = cA + (size_t)(t + 1) * kstep;
            const char* a2 = last ? nA : cA + (size_t)(t + 2) * kstep; const char* b2 = last ? nB : cB + (size_t)(t + 2) * kstep;
            const char* a3 = a2 + kstep; const char* b3 = b2 + kstep;
            PG8_LDB(B0, 0, 0); PG8_SCHED; PG8_LDA(At, 0, 0); if constexpr (GA) PG8_STAGE2(PG8_SA(1, 1), a1, vgC[1][0], vgC[1][1]); else PG8_STAGE(PG8_SA(1, 1), a1 + hstepA, voffA);
            PG8_WAIT_L(8); PG8_BAR; PG8_WAIT_L(0); PG8_MMA(0, 0, At, B0); PG8_BAR; PG8_SCHED;
            PG8_LDB(B1, 0, 1); PG8_STAGE(PG8_SB(0, 0), b2, voffB);
            PG8_BAR; PG8_WAIT_L(0); PG8_MMA(0, 1, At, B1); PG8_BAR;
            PG8_LDA(At, 0, 1); if constexpr (GA) PG8_STAGE2(PG8_SA(0, 0), a2, last ? vgN[0][0] : vgC[0][0], last ? vgN[0][1] : vgC[0][1]); else PG8_STAGE(PG8_SA(0, 0), a2, voffA);
            PG8_BAR; PG8_WAIT_L(0); PG8_MMA(1, 0, At, B0); PG8_BAR; PG8_SCHED;
            PG8_STAGE(PG8_SB(0, 1), b2 + hstepB, voffB);
            PG8_WAIT_V(6); PG8_BAR; PG8_MMA(1, 1, At, B1); PG8_BAR;
            PG8_LDB(B0, 1, 0); PG8_SCHED; PG8_LDA(At, 1, 0); if constexpr (GA) PG8_STAGE2(PG8_SA(0, 1), a2, last ? vgN[1][0] : vgC[1][0], last ? vgN[1][1] : vgC[1][1]); else PG8_STAGE(PG8_SA(0, 1), a2 + hstepA, voffA);
            PG8_WAIT_L(8); PG8_BAR; PG8_WAIT_L(0); PG8_MMA(0, 0, At, B0); PG8_BAR; PG8_SCHED;
            PG8_LDB(B1, 1, 1); PG8_STAGE(PG8_SB(1, 0), b3, voffB);
            PG8_BAR; PG8_WAIT_L(0); PG8_MMA(0, 1, At, B1); PG8_BAR;
            PG8_LDA(At, 1, 1); if constexpr (GA) PG8_STAGE2(PG8_SA(1, 0), a3, last ? vgN[0][0] : vgC[0][0], last ? vgN[0][1] : vgC[0][1]); else PG8_STAGE(PG8_SA(1, 0), a3, voffA);
            PG8_BAR; PG8_WAIT_L(0); PG8_MMA(1, 0, At, B0); PG8_BAR; PG8_SCHED;
            PG8_STAGE(PG8_SB(1, 1), b3 + hstepB, voffB);
            PG8_WAIT_V(6); PG8_BAR; PG8_MMA(1, 1, At, B1); PG8_BAR;
        }
        asm volatile("s_nop 15\n\ts_nop 15" ::: "memory");
        E(acc, cur, wr, wc, fr, fq);
        if (!has_next) break;
#pragma unroll
        for (int a = 0; a < 2; ++a)
#pragma unroll
            for (int b = 0; b < 2; ++b)
#pragma unroll
                for (int m = 0; m < 4; ++m)
#pragma unroll
                    for (int n = 0; n < 2; ++n) acc[a][b][m][n] = (f32x4){0.f, 0.f, 0.f, 0.f};
        cur = nxt; cA = nA; cB = nB; ++ui;
        if constexpr (GA) { vgC[0][0] = vgN[0][0]; vgC[0][1] = vgN[0][1]; vgC[1][0] = vgN[1][0]; vgC[1][1] = vgN[1][1]; }
    }
    PG8_WAIT_V(0);
    if (wr == 0) PG8_BAR;
    PG8_BAR;
#undef PG8_GOFFS
#undef PG8_STAGE2
#undef PG8_SA
#undef PG8_SB
#undef PG8_STAGE
#undef PG8_LDA
#undef PG8_LDB
#undef PG8_MMA
#undef PG8_LD32
#undef PG8_WAIT_V
#undef PG8_WAIT_L
#undef PG8_BAR
#undef PG8_SCHED
}
}
using pg8::Unit;


#define BF_SWAP32(a, b) do { auto rr_ = __builtin_amdgcn_permlane32_swap(__float_as_uint(a), __float_as_uint(b), false, false); a = __uint_as_float(rr_[0]) + __uint_as_float(rr_[1]); } while (0)
#define BF_SWAP16(a, b) do { auto rr_ = __builtin_amdgcn_permlane16_swap(__float_as_uint(a), __float_as_uint(b), false, false); a = __uint_as_float(rr_[0]) + __uint_as_float(rr_[1]); } while (0)
DI float xlane8(float v) { return __int_as_float(__builtin_amdgcn_update_dpp(0, __float_as_int(v), 0x128, 0xF, 0xF, true)); }
DI float bfly16(float (&v)[16], int lane) {
#pragma unroll
    for (int j = 0; j < 8; ++j) BF_SWAP32(v[j], v[j + 8]);
#pragma unroll
    for (int j = 0; j < 4; ++j) BF_SWAP16(v[j], v[j + 4]);
    { const bool bit = lane & 8;
#pragma unroll
      for (int j = 0; j < 2; ++j) { const float keep = bit ? v[j + 2] : v[j], send = bit ? v[j] : v[j + 2]; v[j] = keep + xlane8(send); } }
    { const bool bit = lane & 4; const float keep = bit ? v[1] : v[0], send = bit ? v[0] : v[1]; v[0] = keep + xlane_dpp<4>(send); }
    float r = v[0]; r += xlane_dpp<2>(r); r += xlane_dpp<1>(r); return r;
}
DI float bfly32(float (&v)[32], int lane) {
#pragma unroll
    for (int j = 0; j < 16; ++j) BF_SWAP32(v[j], v[j + 16]);
#pragma unroll
    for (int j = 0; j < 8; ++j) BF_SWAP16(v[j], v[j + 8]);
    { const bool bit = lane & 8;
#pragma unroll
      for (int j = 0; j < 4; ++j) { const float keep = bit ? v[j + 4] : v[j], send = bit ? v[j] : v[j + 4]; v[j] = keep + xlane8(send); } }
    { const bool bit = lane & 4;
#pragma unroll
      for (int j = 0; j < 2; ++j) { const float keep = bit ? v[j + 2] : v[j], send = bit ? v[j] : v[j + 2]; v[j] = keep + xlane_dpp<4>(send); } }
    { const bool bit = lane & 2; const float keep = bit ? v[1] : v[0], send = bit ? v[0] : v[1]; v[0] = keep + xlane_dpp<2>(send); }
    float r = v[0]; r += xlane_dpp<1>(r); return r;
}
DI f32x4 ld4(const float* p) { return *(const f32x4*)p; }
DI f32x4 bf4(u32x2 w) { return (f32x4){bflo(w.x), bfhi(w.x), bflo(w.y), bfhi(w.y)}; }
DI f32x4 f8x4(unsigned w) { const f32x2 lo = __builtin_amdgcn_cvt_pk_f32_fp8((int)w, false), hi = __builtin_amdgcn_cvt_pk_f32_fp8((int)w, true); return (f32x4){lo[0], lo[1], hi[0], hi[1]}; }

DI void tr8_load(const int tid, const float* src, size_t ld_src, f32x4 (&v)[4]) {
#pragma unroll
    for (int it = 0; it < 4; ++it) { const int k = 4 * (tid >> 5) + it, n4 = (tid & 31) * 4; v[it] = ld4(src + (size_t)k * ld_src + n4); }
}
DI void tr8_finish(const int tid, const f32x4 (&v)[4], unsigned char* dst, size_t ld_dst, LAS float* Tl) {
    LAS unsigned* Tw = (LAS unsigned*)Tl;
    __syncthreads();
    { const int kq = tid >> 5, nq = tid & 31;
#pragma unroll
      for (int j = 0; j < 4; ++j) Tw[(4 * nq + j) * 17 + kq] = pk_fp8x4(v[0][j] * 64.f, v[1][j] * 64.f, v[2][j] * 64.f, v[3][j] * 64.f); }
    __syncthreads();
    { const int n = tid >> 2, kq = tid & 3; const LAS unsigned* rp = Tw + n * 17 + 4 * kq;
      u32x4 w; w.x = rp[0]; w.y = rp[1]; w.z = rp[2]; w.w = rp[3];
      *(u32x4*)(dst + (size_t)n * ld_dst + kq * 16) = w; }
}
DI void tr_tile8(const int tid, const float* src, size_t ld_src, unsigned char* dst, size_t ld_dst, LAS float* Tl) {
    f32x4 v[4]; tr8_load(tid, src, ld_src, v); tr8_finish(tid, v, dst, ld_dst, Tl);
}
DI void tr16_finish(const int tid, const f32x4 (&v)[4], bf16_t* dst, size_t ld_dst, LAS float* Tl) {
    __syncthreads();
#pragma unroll
    for (int it = 0; it < 4; ++it) { const int k = 4 * (tid >> 5) + it, n4 = (tid & 31) * 4;
        Tl[k * 129 + n4] = v[it][0]; Tl[k * 129 + n4 + 1] = v[it][1]; Tl[k * 129 + n4 + 2] = v[it][2]; Tl[k * 129 + n4 + 3] = v[it][3]; }
    __syncthreads();
#pragma unroll
    for (int it = 0; it < 2; ++it) {
        const int n = (tid >> 3) + 64 * it, kq = tid & 7;
        float a[8];
#pragma unroll
        for (int j = 0; j < 8; ++j) a[j] = Tl[(kq * 8 + j) * 129 + n];
        u32x4 w; w.x = pk2(a[0], a[1]); w.y = pk2(a[2], a[3]); w.z = pk2(a[4], a[5]); w.w = pk2(a[6], a[7]);
        *(u32x4*)(dst + (size_t)n * ld_dst + kq * 8) = w;
    }
}

DI bool dense_tile(const Ctx& X, int t, const float*& src, size_t& ld_src, unsigned char*& dst, size_t& ld_dst) {
    if (t < 2304) { const int l = t / 1152, r = t % 1152, kt = r / 72, nt = r % 72, n0 = nt * 128;
        src = X.kp->in[I_WIN] + ((size_t)l * 1024 + kt * 64) * WIN_LD + n0 + (n0 >= 2048 ? 16 : 0); ld_src = WIN_LD;
        dst = X.ws + OFF_win8 + ((size_t)l * NPROJ + n0) * 1024 + kt * 64; ld_dst = 1024; return false; }
    if (t < 2816) { int r = t - 2304; const int l = r / 256; r %= 256; const int i = r / 64; r %= 64; const int kt = r / 8, nt = r % 8;
        src = X.kp->in[I_WBR] + ((size_t)(l * 4 + i) * 512 + kt * 64) * 1024 + nt * 128; ld_src = 1024;
        dst = X.ws + OFF_wbr + ((size_t)l * 1024 + nt * 128) * 2048 + i * 512 + kt * 64; ld_dst = 2048; return false; }
    int r = t - 2816; const int l = r / 128; r %= 128; const int kt = r / 8, nt = r % 8;
    src = X.kp->in[I_WOUT] + ((size_t)l * 1024 + kt * 64) * 1024 + nt * 128; ld_src = 1024;
    dst = X.ws + OFF_wout + ((size_t)l * 1024 + nt * 128) * 1024 + kt * 64; ld_dst = 1024; return false;
}
DI void convert_dense(const Ctx& X, int t_begin, int t_end) {
    LAS float* Tl = (LAS float*)X.lds;
    const float* src; size_t ld_src; unsigned char* dst; size_t ld_dst;
    f32x4 v[4], vn[4], vm[4];
    unsigned char* d0; size_t l0; unsigned char* d1 = nullptr; size_t l1 = 0; bool b0, b1 = false;
    b0 = dense_tile(X, t_begin, src, ld_src, d0, l0); tr8_load(X.tid, src, ld_src, v);
    if (t_begin + 1 < t_end) { b1 = dense_tile(X, t_begin + 1, src, ld_src, d1, l1); tr8_load(X.tid, src, ld_src, vn); }
    for (int t = t_begin; t < t_end; ++t) {
        unsigned char* d2 = nullptr; size_t l2 = 0; bool b2 = false;
        if (t + 2 < t_end) { b2 = dense_tile(X, t + 2, src, ld_src, d2, l2); tr8_load(X.tid, src, ld_src, vm); }
        if (b0) tr16_finish(X.tid, v, (bf16_t*)d0, l0, Tl); else tr8_finish(X.tid, v, d0, l0, Tl);
#pragma unroll
        for (int i = 0; i < 4; ++i) { v[i] = vn[i]; vn[i] = vm[i]; }
        d0 = d1; l0 = l1; b0 = b1; d1 = d2; l1 = l2; b1 = b2;
    }
    __syncthreads();
}
DI void phase_pro(const Ctx& X) {
    const int tid = X.tid, lane = X.lane, wv = X.wv;
    LAS float* sc = (LAS float*)X.lds;
    LAS float* red = (LAS float*)(X.lds + 36864);
    for (int i = tid; i < 9 * 1024; i += NTHR) { const float v = (i < 8192) ? X.kp->in[I_C][i] : X.kp->in[I_CCTX][i - 8192]; sc[i] = v / (1.f + expf(-v)); }
    __syncthreads();
    float* modv = (float*)(X.ws + OFF_modv);
    for (int w = X.bid; w < 192; w += X.G) {
        const int l = w / 96, cb = w % 96, col = cb * 64 + lane;
        float acc[9];
#pragma unroll
        for (int r = 0; r < 9; ++r) acc[r] = 0.f;
        const float* wm = X.kp->in[I_WMOD] + (size_t)l * 1024 * 6144 + col;
        for (int k = wv * 128; k < wv * 128 + 128; ++k) { const float wk = wm[(size_t)k * 6144];
#pragma unroll
            for (int r = 0; r < 9; ++r) acc[r] += sc[r * 1024 + k] * wk; }
#pragma unroll
        for (int r = 0; r < 9; ++r) red[(wv * 9 + r) * 64 + lane] = acc[r];
        __syncthreads();
        for (int o = tid; o < 576; o += NTHR) { const int r = o >> 6, cc = o & 63; float s = X.kp->in[I_BMOD][l * 6144 + cb * 64 + cc];
#pragma unroll
            for (int q = 0; q < 8; ++q) s += red[(q * 9 + r) * 64 + cc];
            modv[(size_t)(l * 9 + r) * 6144 + cb * 64 + cc] = s; }
        __syncthreads();
    }
    if (X.bid == X.G - 1) {
        float* rope = (float*)(X.ws + OFF_rope);
        for (int i = tid; i < 1024; i += NTHR) { const int p = i >> 4, j = i & 15; const float invf = powf(10000.f, -(float)j / 16.f), ang = (float)p * invf; rope[2 * i] = cosf(ang); rope[2 * i + 1] = sinf(ang); }
    }
    __syncthreads();
    convert_dense(X, (X.bid * 1152) / X.G, ((X.bid + 1) * 1152) / X.G);
}
DI void expert_tile(const Ctx& X, int l, int t, const float*& src, size_t& ld_src, unsigned char*& dst, size_t& ld_dst) {
    if (t < 4096) { const int which = t / 2048; int r = t % 2048; const int e = r / 64; r %= 64; const int kt = r / 4, nt = r % 4;
        src = X.kp->in[which ? I_EU : I_EG] + ((size_t)(l * NE + e) * 1024 + kt * 64) * 512 + nt * 128; ld_src = 512;
        dst = X.ws + OFF_wgu + ((size_t)e * 1024 + nt * 256 + which * 128) * 1024 + kt * 64; ld_dst = 1024; }
    else { int r = t - 4096; const int e = r / 64; r %= 64; const int kt = r / 8, nt = r % 8;
        src = X.kp->in[I_ED] + ((size_t)(l * NE + e) * 512 + kt * 64) * 1024 + nt * 128; ld_src = 1024;
        dst = X.ws + OFF_wdn + ((size_t)e * 1024 + nt * 128) * 512 + kt * 64; ld_dst = 512; }
}
DI void convert_experts(const Ctx& X, int l, int t_begin, int t_end) {
    LAS float* Tl = (LAS float*)X.lds;
    const float* src; size_t ld_src; unsigned char* dst; size_t ld_dst;
    f32x4 v[4], vn[4], vm[4];
    unsigned char* d0; size_t l0; unsigned char* d1 = nullptr; size_t l1 = 0;
    expert_tile(X, l, t_begin, src, ld_src, d0, l0); tr8_load(X.tid, src, ld_src, v);
    if (t_begin + 1 < t_end) { expert_tile(X, l, t_begin + 1, src, ld_src, d1, l1); tr8_load(X.tid, src, ld_src, vn); }
    for (int t = t_begin; t < t_end; ++t) {
        unsigned char* d2 = nullptr; size_t l2 = 0;
        if (t + 2 < t_end) { expert_tile(X, l, t + 2, src, ld_src, d2, l2); tr8_load(X.tid, src, ld_src, vm); }
        tr8_finish(X.tid, v, d0, l0, Tl);
#pragma unroll
        for (int i = 0; i < 4; ++i) { v[i] = vn[i]; vn[i] = vm[i]; }
        d0 = d1; l0 = l1; d1 = d2; l1 = l2;
    }
    __syncthreads();
}

DI void moe_combine(const Ctx& X, int lp, int row, int b, bool isctx, f32x4 (&xv)[4]) {
    const int* tokS = (const int*)(X.ws + OFF_tokS); const float* tokW = (const float*)(X.ws + OFF_tokW);
    const unsigned char* ys = X.ws + OFF_ys;
    const float* ga2 = (const float*)(X.ws + OFF_modv) + (size_t)(lp * 9 + (isctx ? 8 : b)) * 6144 + 5120;
    const int s0 = tokS[row * 2], s1 = tokS[row * 2 + 1]; const float w0 = tokW[row * 2] * 0.0625f, w1 = tokW[row * 2 + 1] * 0.0625f;
#pragma unroll
    for (int i = 0; i < 4; ++i) { const int d = X.lane * 4 + 256 * i;
        const int q0 = *(const int*)(ys + (size_t)s0 * 1024 + d), q1 = *(const int*)(ys + (size_t)s1 * 1024 + d);
        const f32x2 a0 = __builtin_amdgcn_cvt_pk_f32_fp8(q0, false), a1 = __builtin_amdgcn_cvt_pk_f32_fp8(q0, true), c0 = __builtin_amdgcn_cvt_pk_f32_fp8(q1, false), c1 = __builtin_amdgcn_cvt_pk_f32_fp8(q1, true);
        const f32x4 y0 = {a0.x, a0.y, a1.x, a1.y}, y1 = {c0.x, c0.y, c1.x, c1.y};
        xv[i] += ld4(ga2 + d) * (y0 * w0 + y1 * w1); }
}

DI void phase_pre(const Ctx& X, int l) {
    const int tid = X.tid, lane = X.lane;
    LAS float* wT = (LAS float*)X.lds;
    { const float* win = X.kp->in[I_WIN] + (size_t)l * D * WIN_LD;
      for (int i = tid; i < 4 * 1024; i += NTHR) { const int d = i >> 2, j0 = (i & 3) * 4; const f32x4 v = ld4(win + (size_t)d * WIN_LD + 2048 + j0);
          wT[j0 * 1024 + d] = v[0]; wT[(j0 + 1) * 1024 + d] = v[1]; wT[(j0 + 2) * 1024 + d] = v[2]; wT[(j0 + 3) * 1024 + d] = v[3]; } }
    __syncthreads();
    const float* g1 = X.kp->in[I_N1G] + l * D; const float* gateb = X.kp->in[I_GATEB] + l * 16;
    const float* modv = (const float*)(X.ws + OFF_modv);
    bf16_t* XS = (bf16_t*)(X.ws + OFF_xsb);
    float* gI = (float*)(X.ws + OFF_gI); float* gF = (float*)(X.ws + OFF_gF);
    f32x4 nx[4];
#define PRE_FETCH(rw) do { if (l == 0) { const int b_ = (rw) / TPB, tt_ = (rw) % TPB; const float* s_ = (tt_ < CTX) ? X.kp->in[I_CTX] + ((size_t)b_ * CTX + tt_) * D : X.kp->in[I_X] + ((size_t)b_ * SEQ + (tt_ - CTX)) * D; \
            _Pragma("unroll") for (int i = 0; i < 4; ++i) nx[i] = ld4(s_ + lane * 4 + 256 * i); } \
        else { const bf16_t* s_ = XS + (size_t)(rw) * D; _Pragma("unroll") for (int i = 0; i < 4; ++i) { const u32x2 t_ = *(const u32x2*)(s_ + lane * 4 + 256 * i); nx[i][0] = __uint_as_float(t_.x); nx[i][1] = __uint_as_float(t_.y); } } } while (0)
    const int nwv = X.G * 8, npw = (T + nwv - 1) / nwv, r_begin = (X.bid * 8 + X.wv) * npw, r_end = (r_begin + npw < T) ? r_begin + npw : T;
    const float gb_lane = gateb[lane >> 2];
    int ckey = -1; f32x4 cA[4], cB[4], cG[4];
#pragma unroll
    for (int i = 0; i < 4; ++i) { cA[i] = (f32x4){0.f, 0.f, 0.f, 0.f}; cB[i] = cA[i]; cG[i] = cA[i]; }
    int tsv = 0; float twv = 0.f;
    if (l > 0) { const int rr_ = r_begin + (lane >> 1); if (rr_ < r_end) { tsv = ((const int*)(X.ws + OFF_tokS))[rr_ * 2 + (lane & 1)]; twv = ((const float*)(X.ws + OFF_tokW))[rr_ * 2 + (lane & 1)] * 0.0625f; } }
    if (r_begin < r_end) PRE_FETCH(r_begin);
    for (int row = r_begin; row < r_end; ++row) {
        const int b = row / TPB, tt = row % TPB; const bool isctx = tt < CTX;
        const int key = isctx ? 8 : b;
        if (key != ckey) { ckey = key; const float* modr = modv + (size_t)(l * 9 + key) * 6144;
#pragma unroll
            for (int i = 0; i < 4; ++i) { const int d = lane * 4 + 256 * i; cA[i] = ld4(g1 + d) * (ld4(modr + 1024 + d) + 1.f); cB[i] = ld4(modr + d);
                if (l > 0) cG[i] = ld4(modv + (size_t)((l - 1) * 9 + key) * 6144 + 5120 + d); } }
        f32x4 xv[4];
        if (l == 0) {
#pragma unroll
            for (int i = 0; i < 4; ++i) xv[i] = nx[i];
        } else {
#pragma unroll
            for (int i = 0; i < 4; ++i) { u32x2 t_; t_.x = __float_as_uint(nx[i][0]); t_.y = __float_as_uint(nx[i][1]); xv[i] = bf4(t_); }
        }
        if (row + 1 < r_end) PRE_FETCH(row + 1);
        if (l > 0) {
            { const unsigned char* ys = X.ws + OFF_ys; const int j2 = 2 * (row - r_begin);
              int s0, s1; float w0, w1;
              if (npw <= 32) { s0 = __builtin_amdgcn_readlane(tsv, j2); s1 = __builtin_amdgcn_readlane(tsv, j2 + 1);
                  w0 = __uint_as_float(__builtin_amdgcn_readlane(__float_as_uint(twv), j2)); w1 = __uint_as_float(__builtin_amdgcn_readlane(__float_as_uint(twv), j2 + 1)); }
              else { const int* tokS = (const int*)(X.ws + OFF_tokS); const float* tokW = (const float*)(X.ws + OFF_tokW); s0 = tokS[row * 2]; s1 = tokS[row * 2 + 1]; w0 = tokW[row * 2] * 0.0625f; w1 = tokW[row * 2 + 1] * 0.0625f; }
#pragma unroll
              for (int i = 0; i < 4; ++i) { const int d = lane * 4 + 256 * i;
                  const int q0 = *(const int*)(ys + (size_t)s0 * 1024 + d), q1 = *(const int*)(ys + (size_t)s1 * 1024 + d);
                  const f32x2 a0 = __builtin_amdgcn_cvt_pk_f32_fp8(q0, false), a1 = __builtin_amdgcn_cvt_pk_f32_fp8(q0, true), c0 = __builtin_amdgcn_cvt_pk_f32_fp8(q1, false), c1 = __builtin_amdgcn_cvt_pk_f32_fp8(q1, true);
                  const f32x4 y0 = {a0.x, a0.y, a1.x, a1.y}, y1 = {c0.x, c0.y, c1.x, c1.y};
                  xv[i] += cG[i] * (y0 * w0 + y1 * w1); } }
#pragma unroll
            for (int i = 0; i < 4; ++i) { u32x2 w_; w_.x = pk2(xv[i][0], xv[i][1]); w_.y = pk2(xv[i][2], xv[i][3]); *(u32x2*)(XS + (size_t)row * D + lane * 4 + 256 * i) = w_; } }
        float ss = 0.f;
#pragma unroll
        for (int i = 0; i < 4; ++i) ss += xv[i][0] * xv[i][0] + xv[i][1] * xv[i][1] + xv[i][2] * xv[i][2] + xv[i][3] * xv[i][3];
        ss = wave_sum(ss); const float rr = rsqrtf(ss * (1.f / 1024.f) + EPS);
        f32x4 hv[4];
#pragma unroll
        for (int i = 0; i < 4; ++i) { const int d = lane * 4 + 256 * i;
            hv[i] = xv[i] * rr * cA[i] + cB[i];
            *(unsigned*)(X.ws + OFF_h8in + (size_t)row * D + d) = pk_fp8x4(hv[i][0], hv[i][1], hv[i][2], hv[i][3]); }
        float ga[16];
#pragma unroll
        for (int j = 0; j < 16; ++j) { f32x2 pp = {0.f, 0.f};
#pragma unroll
            for (int i = 0; i < 4; ++i) { const f32x4 w = *(const LAS f32x4*)(wT + j * 1024 + lane * 4 + 256 * i);
                pp += (f32x2){hv[i][0], hv[i][1]} * (f32x2){w[0], w[1]}; pp += (f32x2){hv[i][2], hv[i][3]} * (f32x2){w[2], w[3]}; }
            ga[j] = pp.x + pp.y; if ((j & 3) == 3) __builtin_amdgcn_sched_barrier(0); }
        const float gsum = bfly16(ga, lane);
        if ((lane & 3) == 0) { const int j = lane >> 2;
            const float g = gsum + gb_lane; const int dir = j >> 3, ty = (j >> 2) & 1, hd = j & 3;
            const size_t gi = ((size_t)(dir * NB + b) * 4 + hd) * TPB + tt;
            if (ty == 0) gI[gi] = g; else gF[gi] = fminf(g, 0.f) - __logf(1.f + __expf(-fabsf(g))); }
    }
    __syncthreads();
}

DI void phase_elt(const Ctx& X, int l) {
    const int tid = X.tid, lane = X.lane;
    LAS float* ropeL = (LAS float*)X.lds;
    { const float* rope = (const float*)(X.ws + OFF_rope); for (int i = tid; i < 2048; i += NTHR) ropeL[i] = rope[i]; }
    __syncthreads();
    bf16_t* PA = (bf16_t*)(X.ws + uo_projA(X.rs));
    const int pi = lane & 31, hsel = lane >> 5, fj = pi & 15;
    const float gk0 = X.kp->in[I_KNORM][l * 64 + 2 * pi], gk1 = X.kp->in[I_KNORM][l * 64 + 2 * pi + 1];
    for (int row = X.bid * 8 + X.wv; row < X.rs; row += X.G * 8) {
        const int tt = row % TPB; const bool isctx = tt < CTX; const int t = tt - CTX;
        const int pos = (pi < 16) ? (t >> 6) : (t & 63);
        float cs = 1.f, sn = 0.f; if (!isctx) { cs = ropeL[(pos * 16 + fj) * 2]; sn = ropeL[(pos * 16 + fj) * 2 + 1]; }
        bf16_t* pr = PA + (size_t)row * NPA;
        unsigned xin[2];
#pragma unroll
        for (int st = 0; st < 2; ++st) xin[st] = *(const unsigned*)(pr + (st == 0 ? C_GK : C_WK) + 64 * hsel + 2 * pi);
        asm volatile("" ::: "memory");
#pragma unroll
        for (int st = 0; st < 2; ++st) {
            float x0 = bflo(xin[st]), x1 = bfhi(xin[st]);
            if (st == 0) { float ss = x0 * x0 + x1 * x1;
#pragma unroll
                for (int o = 16; o >= 1; o >>= 1) ss += __shfl_xor(ss, o);
                const float rr = rsqrtf(ss * (1.f / 64.f) + EPS); x0 = x0 * rr * gk0; x1 = x1 * rr * gk1; }
            { const float y0 = x0 * cs - x1 * sn, y1 = x0 * sn + x1 * cs; x0 = y0; x1 = y1; }
            *(unsigned*)(pr + (st == 0 ? C_GK : C_WK) + 64 * hsel + 2 * pi) = pk2(x0, x1);
        }
    }
    { const bf16_t* HALO = (const bf16_t*)(X.ws + OFF_halo); const float* cwg = X.kp->in[I_CONVW] + (size_t)l * 3 * 1024; const float* cbg = X.kp->in[I_CONVB] + l * 1024;
      const int ntask = (X.rs / 68) * 8;
      for (int task = X.bid * 8 + X.wv; task < ntask; task += X.G * 8) {
        const int rg = task >> 3, c = (task & 7) * 128 + lane * 2, r0 = rg * 68, t0 = r0 % TPB;
        const float w00 = cwg[c], w01 = cwg[c + 1], w10 = cwg[1024 + c], w11 = cwg[1024 + c + 1], w20 = cwg[2048 + c], w21 = cwg[2048 + c + 1], b0 = cbg[c], b1 = cbg[c + 1];
        const float sc = c >= 512 ? 0.08838834764831845f : 1.f;
        bf16_t* base = PA + (size_t)r0 * NPA + c;
        unsigned xprev = (t0 == 0) ? 0u : *(const unsigned*)(HALO + ((size_t)(rg - 1) * 2 + 1) * 1024 + c);
        const unsigned xlast = (t0 + 68 == TPB) ? 0u : *(const unsigned*)(HALO + ((size_t)(rg + 1) * 2) * 1024 + c);
        unsigned xcur = *(const unsigned*)base;
#pragma unroll
        for (int hb = 0; hb < 2; ++hb) {
            unsigned xr[36]; xr[0] = xprev; xr[1] = xcur;
#pragma unroll
            for (int i = 1; i < 34; ++i) xr[i + 1] = *(const unsigned*)(base + (size_t)(hb * 34 + i) * NPA);
            xr[35] = hb ? xlast : *(const unsigned*)(base + (size_t)34 * NPA);
            asm volatile("" ::: "memory");
#pragma unroll
            for (int i = 0; i < 34; ++i) {
                const int tb = t0 + hb * 34 + i; const bool ss = (tb == 0 || tb == CTX), se = (tb == CTX - 1 || tb == TPB - 1);
                const unsigned xp = ss ? 0u : xr[i], xn = se ? 0u : xr[i + 2];
                const float a0 = w00 * bflo(xp) + w10 * bflo(xr[i + 1]) + w20 * bflo(xn) + b0, a1 = w01 * bfhi(xp) + w11 * bfhi(xr[i + 1]) + w21 * bfhi(xn) + b1;
                *(unsigned*)(base + (size_t)(hb * 34 + i) * NPA) = pk2(siluf_(a0) * sc, siluf_(a1) * sc);
            }
            xprev = xr[34]; xcur = xr[35];
        }
      }
    }
    __syncthreads();
}

DI void phase_cmb(const Ctx& X, int l) {
    const int lane = X.lane;
    const bf16_t* PA = (const bf16_t*)(X.ws + uo_projA(X.rs)); const bf16_t* hp = (const bf16_t*)(X.ws + uo_hpart(X.rs)); bf16_t* bc = (bf16_t*)(X.ws + uo_bcat(X.rs));
    const float* ng = X.kp->in[I_MNORMG] + l * 512;
    float ng0[4], ng1[4];
#pragma unroll
    for (int hd = 0; hd < 4; ++hd) { ng0[hd] = ng[hd * 128 + lane * 2]; ng1[hd] = ng[hd * 128 + lane * 2 + 1]; }
    for (int row = X.bid * 8 + X.wv; row < X.rs; row += X.G * 8) {
        unsigned hf[4], hb[4], o[4];
#pragma unroll
        for (int hd = 0; hd < 4; ++hd) { const int c = hd * 128 + lane * 2;
            hf[hd] = *(const unsigned*)(hp + (size_t)row * 512 + c); hb[hd] = *(const unsigned*)(hp + ((size_t)X.rs + row) * 512 + c); o[hd] = *(const unsigned*)(PA + (size_t)row * NPA + C_MO + c); }
#pragma unroll
        for (int hd = 0; hd < 4; ++hd) { const int c = hd * 128 + lane * 2;
            const float v0 = bflo(hf[hd]) + bflo(hb[hd]), v1 = bfhi(hf[hd]) + bfhi(hb[hd]);
            const float ss = wave_sum(v0 * v0 + v1 * v1), rr = rsqrtf(ss * (1.f / 128.f) + EPS);
            *(unsigned short*)((unsigned char*)bc + (size_t)row * 2048 + c) = (unsigned short)pk_fp8x4(v0 * rr * ng0[hd] * sigmoidf_(bflo(o[hd])), v1 * rr * ng1[hd] * sigmoidf_(bfhi(o[hd])), 0.f, 0.f); }
    }
}

DI void phase_rte(const Ctx& X, int l) {
    const int tid = X.tid, lane = X.lane;
    LAS float* wrT = (LAS float*)X.lds;
    for (int i = tid; i < 8 * 1024; i += NTHR) { const int d = i >> 3, e0 = (i & 7) * 4; const f32x4 v = ld4(X.kp->in[I_WR] + d * 32 + e0);
        wrT[e0 * 1024 + d] = v[0]; wrT[(e0 + 1) * 1024 + d] = v[1]; wrT[(e0 + 2) * 1024 + d] = v[2]; wrT[(e0 + 3) * 1024 + d] = v[3]; }
    __syncthreads();
    const float* g2 = X.kp->in[I_N2G] + l * D; const float* modv = (const float*)(X.ws + OFF_modv);
    const bf16_t* XS = (const bf16_t*)(X.ws + OFF_xsb); unsigned char* H8 = X.ws + OFF_h8;
    int* tokE = (int*)(X.ws + OFF_tokE); int* tokS = (int*)(X.ws + OFF_tokS); float* tokW = (float*)(X.ws + OFF_tokW);
    unsigned* cnt = X.ctl + CW_CNT + l * 32 * 64;
    LAS unsigned* lcnt = (LAS unsigned*)(X.lds + MISC_OFF + 3072);
    if (tid < 64) lcnt[tid] = 0u;
    __syncthreads();
    const float rbias = X.kp->in[I_RB][lane & 31];
    const int nidx = l > 0 ? NB * SEQ : T;
    LAS float* lg2 = (LAS float*)(X.lds + MISC_OFF + 8192) + X.wv * 64;
    u32x2 nx[2][4];
#define RTE_ROW(ix) (l > 0 ? ((ix) / SEQ) * TPB + CTX + (ix) % SEQ : (ix))
#define RTE_SRC(rw) (XS + (size_t)(rw) * D)
    const int nwv = X.G * 8, npw = (nidx + nwv - 1) / nwv, idx0 = (X.bid * 8 + X.wv) * npw, idx1 = (idx0 + npw < nidx) ? idx0 + npw : nidx, stride = 1;
    int ckey = -1; f32x4 cA[4], cB[4];
#pragma unroll
    for (int i = 0; i < 4; ++i) { cA[i] = (f32x4){0.f, 0.f, 0.f, 0.f}; cB[i] = cA[i]; }
#define RTE_FETCH(ixa) do { _Pragma("unroll") for (int t_ = 0; t_ < 2; ++t_) { int ix_ = (ixa) + t_ * stride; if (ix_ >= idx1) ix_ = (ixa); if (ix_ < idx1) { const bf16_t* s_ = RTE_SRC(RTE_ROW(ix_)); \
        _Pragma("unroll") for (int i = 0; i < 4; ++i) nx[t_][i] = *(const u32x2*)(s_ + lane * 4 + 256 * i); } } } while (0)
    if (idx0 < idx1) RTE_FETCH(idx0);
    for (int idx = idx0; idx < idx1; idx += 2 * stride) {
        const bool has2 = idx + stride < idx1;
        int rows[2]; rows[0] = RTE_ROW(idx); rows[1] = has2 ? RTE_ROW(idx + stride) : rows[0];
        f32x4 hv[2][4];
        {
            f32x4 xv[2][4]; float ss[2] = {0.f, 0.f};
#pragma unroll
            for (int t = 0; t < 2; ++t)
#pragma unroll
                for (int i = 0; i < 4; ++i) { xv[t][i] = bf4(nx[t][i]); ss[t] += xv[t][i][0] * xv[t][i][0] + xv[t][i][1] * xv[t][i][1] + xv[t][i][2] * xv[t][i][2] + xv[t][i][3] * xv[t][i][3]; }
            if (idx + 2 * stride < idx1) RTE_FETCH(idx + 2 * stride);
#pragma unroll
            for (int t = 0; t < 2; ++t) {
                const int row = rows[t], b = row / TPB, tt = row % TPB; const bool isctx = tt < CTX; const int key = isctx ? 8 : b;
                if (key != ckey) { ckey = key; const float* modr = modv + (size_t)(l * 9 + key) * 6144;
#pragma unroll
                    for (int i = 0; i < 4; ++i) { const int d = lane * 4 + 256 * i; cA[i] = ld4(g2 + d) * (ld4(modr + 4096 + d) + 1.f); cB[i] = ld4(modr + 3072 + d); } }
                const float rr = rsqrtf(wave_sum(ss[t]) * (1.f / 1024.f) + EPS);
#pragma unroll
                for (int i = 0; i < 4; ++i) { const int d = lane * 4 + 256 * i;
                    hv[t][i] = xv[t][i] * rr * cA[i] + cB[i];
                    if (t == 0 || has2) *(unsigned*)(H8 + (size_t)row * D + d) = pk_fp8x4(hv[t][i][0], hv[t][i][1], hv[t][i][2], hv[t][i][3]); }
            }
        }
        {
            float a0[32], a1[32];
#pragma unroll
            for (int e = 0; e < 32; ++e) { f32x2 p0 = {0.f, 0.f}, p1 = {0.f, 0.f};
#pragma unroll
                for (int i = 0; i < 4; ++i) { const f32x4 w = *(const LAS f32x4*)(wrT + e * 1024 + lane * 4 + 256 * i);
                    const f32x2 wl = {w[0], w[1]}, wh = {w[2], w[3]};
                    p0 += (f32x2){hv[0][i][0], hv[0][i][1]} * wl; p0 += (f32x2){hv[0][i][2], hv[0][i][3]} * wh;
                    p1 += (f32x2){hv[1][i][0], hv[1][i][1]} * wl; p1 += (f32x2){hv[1][i][2], hv[1][i][3]} * wh; }
                a0[e] = p0.x + p0.y; a1[e] = p1.x + p1.y; }
            const float l0 = bfly32(a0, lane), l1 = bfly32(a1, lane);
            if ((lane & 1) == 0) { lg2[lane >> 1] = l0; lg2[32 + (lane >> 1)] = l1; }
            asm volatile("s_waitcnt lgkmcnt(0)" ::: "memory");
        }
#pragma unroll
        for (int t = 0; t < 2; ++t) {
            if (t == 1 && !has2) break;
            const int row = rows[t];
            const float logit = lg2[t * 32 + (lane & 31)];
            const float score = 1.f / (1.f + expf(-logit)), sel = score + rbias;
            float m1 = sel; m1 = fmaxf(m1, xlane_dpp<1>(m1)); m1 = fmaxf(m1, xlane_dpp<2>(m1)); m1 = fmaxf(m1, xlane_dpp<4>(m1));
            const unsigned long long segm = 0xFFull << (lane & 56);
            const int i1 = __ffsll((long long)(__ballot(sel == m1) & segm)) - 1;
            const float v2 = (lane == i1) ? -3.0e38f : sel;
            float m2 = v2; m2 = fmaxf(m2, xlane_dpp<1>(m2)); m2 = fmaxf(m2, xlane_dpp<2>(m2)); m2 = fmaxf(m2, xlane_dpp<4>(m2));
            const int i2 = __ffsll((long long)(__ballot(v2 == m2) & segm)) - 1;
            const float gs = m1 + m2;
            const float gs0 = lane_bcast(gs, 0), gs1 = lane_bcast(gs, 8), gs2 = lane_bcast(gs, 16), gs3 = lane_bcast(gs, 24);
            int grp = 0; float gb = gs0; if (gs1 > gb) { gb = gs1; grp = 1; } if (gs2 > gb) { gb = gs2; grp = 2; } if (gs3 > gb) { gb = gs3; grp = 3; }
            const int e1 = __builtin_amdgcn_readlane(i1, grp * 8), e2 = __builtin_amdgcn_readlane(i2, grp * 8);
            const float w1 = lane_bcast(score, e1), w2 = lane_bcast(score, e2), wn = 1.f / (w1 + w2);
            if (lane == 0) {
                const unsigned p1 = __hip_atomic_fetch_add(lcnt + e1, 1u, __ATOMIC_RELAXED, __HIP_MEMORY_SCOPE_WORKGROUP), p2 = __hip_atomic_fetch_add(lcnt + e2, 1u, __ATOMIC_RELAXED, __HIP_MEMORY_SCOPE_WORKGROUP);
                tokE[row * 2] = e1; tokE[row * 2 + 1] = e2; tokS[row * 2] = (int)p1; tokS[row * 2 + 1] = (int)p2; tokW[row * 2] = w1 * wn; tokW[row * 2 + 1] = w2 * wn;
            }
        }
    }
#undef RTE_FETCH
    __syncthreads();
    if (tid < 32) lcnt[32 + tid] = lcnt[tid] ? atomicAdd(cnt + tid * 64, lcnt[tid]) : 0u;
    __syncthreads();
    for (int k = lane; ; k += 64) {
        const int idx = idx0 + (k >> 1); if (idx >= idx1) break;
        const int row = RTE_ROW(idx);
        { const int e_ = tokE[row * 2 + (k & 1)], pf_ = tokS[row * 2 + (k & 1)] + (int)lcnt[32 + e_];
          tokS[row * 2 + (k & 1)] = pf_; ((int*)(X.ws + OFF_xs))[e_ * T + pf_] = row; }
    }
    __syncthreads();
}

DI void build_expert_tables(const Ctx& X, int l) {
    LAS int* baseE = (LAS int*)(X.lds + MISC_OFF + 4096); LAS int* tileE = (LAS int*)(X.lds + MISC_OFF + 4352);
    __syncthreads();
    if (X.wv == 0) {
        const int c = (X.lane < 32) ? (int)X.ctl[CW_CNT + (l * 32 + X.lane) * 64] : 0, pad = (c + 255) & ~255;
        int inc = pad;
#pragma unroll
        for (int o = 1; o < 32; o <<= 1) { const int t = __shfl_up(inc, o); if (X.lane >= o) inc += t; }
        if (X.lane < 32) { baseE[X.lane] = inc - pad; ((LAS int*)(X.lds + MISC_OFF + 6144))[X.lane] = c; }
        if (X.lane == 31) { baseE[32] = inc; baseE[33] = inc >> 8; }
    }
    __syncthreads();
    if (X.tid < 320) { const int r0 = X.tid * 256; int e = 0;
#pragma unroll
        for (int k = 1; k < 32; ++k) e += (baseE[k] <= r0) ? 1 : 0;
        tileE[X.tid] = e; }
    __syncthreads();
}
DI void phase_fin(const Ctx& X) {
    const int lane = X.lane; const float* fg = X.kp->in[I_FING];
    const int* tokS = (const int*)(X.ws + OFF_tokS); const float* tokW = (const float*)(X.ws + OFF_tokW);
    const unsigned char* ys = X.ws + OFF_ys; const bf16_t* XS = (const bf16_t*)(X.ws + OFF_xsb);
    const int nwv = X.G * 8, npw = (NB * SEQ + nwv - 1) / nwv, rb0 = (X.bid * 8 + X.wv) * npw, rb1 = (rb0 + npw < NB * SEQ) ? rb0 + npw : NB * SEQ, stride = 1;
    f32x4 cF[4], cG[4]; int ckey = -1;
#pragma unroll
    for (int i = 0; i < 4; ++i) { cF[i] = ld4(fg + lane * 4 + 256 * i); cG[i] = (f32x4){0.f, 0.f, 0.f, 0.f}; }
    for (int r0 = rb0; r0 < rb1; r0 += 4 * stride) {
        int rr_[4], row[4]; u32x2 xs[4][4]; int sl[4][2]; float wt[4][2];
#pragma unroll
        for (int k = 0; k < 4; ++k) { int r = r0 + k * stride; if (r >= rb1) r = r0; rr_[k] = r; row[k] = (r / SEQ) * TPB + CTX + r % SEQ;
            sl[k][0] = tokS[row[k] * 2]; sl[k][1] = tokS[row[k] * 2 + 1]; wt[k][0] = tokW[row[k] * 2] * 0.0625f; wt[k][1] = tokW[row[k] * 2 + 1] * 0.0625f;
#pragma unroll
            for (int i = 0; i < 4; ++i) xs[k][i] = *(const u32x2*)(XS + (size_t)row[k] * D + lane * 4 + 256 * i); }
        int q[4][2][4];
#pragma unroll
        for (int k = 0; k < 4; ++k)
#pragma unroll
            for (int i = 0; i < 4; ++i) { const int d = lane * 4 + 256 * i; q[k][0][i] = *(const int*)(ys + (size_t)sl[k][0] * 1024 + d); q[k][1][i] = *(const int*)(ys + (size_t)sl[k][1] * 1024 + d); }
#pragma unroll
        for (int k = 0; k < 4; ++k) {
            if (k > 0 && r0 + k * stride >= rb1) break;
            const int b = rr_[k] / SEQ;
            if (b != ckey) { ckey = b; const float* ga2 = (const float*)(X.ws + OFF_modv) + (size_t)(9 + b) * 6144 + 5120;
#pragma unroll
                for (int i = 0; i < 4; ++i) cG[i] = ld4(ga2 + lane * 4 + 256 * i); }
            f32x4 xv[4]; float ss = 0.f;
#pragma unroll
            for (int i = 0; i < 4; ++i) { const int d = lane * 4 + 256 * i;
                const f32x2 a0 = __builtin_amdgcn_cvt_pk_f32_fp8(q[k][0][i], false), a1 = __builtin_amdgcn_cvt_pk_f32_fp8(q[k][0][i], true), c0 = __builtin_amdgcn_cvt_pk_f32_fp8(q[k][1][i], false), c1 = __builtin_amdgcn_cvt_pk_f32_fp8(q[k][1][i], true);
                const f32x4 y0 = {a0.x, a0.y, a1.x, a1.y}, y1 = {c0.x, c0.y, c1.x, c1.y};
                xv[i] = bf4(xs[k][i]) + cG[i] * (y0 * wt[k][0] + y1 * wt[k][1]);
                ss += xv[i][0] * xv[i][0] + xv[i][1] * xv[i][1] + xv[i][2] * xv[i][2] + xv[i][3] * xv[i][3]; }
            ss = wave_sum(ss); const float rr = rsqrtf(ss * (1.f / 1024.f) + EPS);
            float* xr = X.out + (size_t)rr_[k] * D;
#pragma unroll
            for (int i = 0; i < 4; ++i) *(f32x4*)(xr + lane * 4 + 256 * i) = xv[i] * rr * cF[i];
        }
    }
}

struct TileSched {
    static constexpr bool GATHER = false; DI int row_of(int r) const { return r; }
    int nM, nN, G, c, lat;
    DI bool next(int i, Unit& u) const { const int L = i * G + c; if (L >= nM * nN) return false; int j, pn; pg8::tile_order(L, nM, nN, j, pn);
        u.pm = lat ? (j >> 4) * 17 + 1 + (j & 15) : j; u.pn = pn; u.ko = 0; u.aux = 0; u.kt = 0; return true; }
};
struct MrgSched0 { static constexpr bool GATHER = false; DI int row_of(int r) const { return r; } int nb, G, c;
    DI bool next(int i, Unit& u) const { int L = i * G + c; const int nfull = nb * 64;
        if (L < nfull) { int j, pn; pg8::tile_order(L, nb * 16, 4, j, pn); u.pm = (j >> 4) * 17 + 1 + (j & 15); u.pn = pn; u.ko = 0; u.aux = 0; u.kt = 0; return true; }
        L -= nfull; if (L >= nb * 16) return false;
        const int c4 = L >> 2, br = L & 3; u.pm = (c4 >> 2) * 17; u.pn = c4 & 3; u.ko = br * 512; u.aux = 8 + br + (c4 << 4); u.kt = 4; return true; }
};
struct ExpSched { static constexpr bool GATHER = false; DI int row_of(int r) const { return r; } const LAS int* tileE; int ntiles, G, c;
    DI bool next(int i, Unit& u) const { const int L = i * G + c, rt = L >> 2; if (rt >= ntiles) return false; const int pnl = L & 3; u.pm = rt; u.pn = __builtin_amdgcn_readfirstlane(tileE[rt]) * 4 + pnl; u.ko = 0; u.aux = pnl; u.kt = 0; return true; }
};
struct ExpSchedG { static constexpr bool GATHER = true; const int* etok; const LAS int* baseE; const LAS int* cntE; int padrow;
    DI int row_of(int r) const { const int e = tileE[r >> 8], rel = r - baseE[e]; return rel < cntE[e] ? etok[e * T + rel] : padrow; }
    const LAS int* tileE; int ntiles, G, c;
    DI bool next(int i, Unit& u) const { const int L = i * G + c, rt = L >> 2; if (rt >= ntiles) return false; const int pnl = L & 3; u.pm = rt; u.pn = __builtin_amdgcn_readfirstlane(tileE[rt]) * 4 + pnl; u.ko = 0; u.aux = pnl; u.kt = 0; return true; }
};
typedef f32x4 AccT[2][2][4][2];
struct EpiProj { static constexpr int HOOK_T = 0; static constexpr bool PERM = true; bf16_t* PA; bf16_t* PG; bf16_t* HALO;
    DI void operator()(const AccT& acc, const Unit& u, int wr, int wc, int fr, int fq) const {
        const int colt = u.pn * 256; bf16_t* base; int ld; if (colt < NPA) { base = PA + colt; ld = NPA; } else { base = PG + (colt - NPA); ld = NPG; }
#pragma unroll
        for (int ai = 0; ai < 2; ++ai)
#pragma unroll
            for (int m = 0; m < 4; ++m) { const int row = u.pm * 256 + ai * 128 + wr * 64 + m * 16 + fr; bf16_t* rp = base + (size_t)row * ld + wc * 32 + 8 * fq;
#pragma unroll
                for (int bj = 0; bj < 2; ++bj) { f32x4 v0 = acc[ai][bj][m][0], v1 = acc[ai][bj][m][1];
                    constexpr float GS = 0.015625f;
                    if (colt >= NPA) {
#pragma unroll
                        for (int q = 0; q < 4; ++q) { v0[q] = fmaf(__expf(-fmaxf(v0[q], -10.f)), GS, GS); v1[q] = fmaf(__expf(-fmaxf(v1[q], -10.f)), GS, GS); } }
                    u32x4 w; w.x = pk2(v0[0], v0[1]); w.y = pk2(v0[2], v0[3]); w.z = pk2(v1[0], v1[1]); w.w = pk2(v1[2], v1[3]);
                    if (colt >= NPA) {
                        unsigned char* gq = (unsigned char*)PG + ((size_t)u.pm * 16 + (u.pn - NPA / 256)) * 65536 + (((ai * 4 + m) * 2 + bj) * 8 + wr * 4 + wc) * 512 + (fr + 32 * (fq & 1)) * 8 + (fq >> 1) * 4;
                        *(unsigned*)gq = pk_fp8x4_nc(v0[0], v0[1], v0[2], v0[3]); *(unsigned*)(gq + 128) = pk_fp8x4_nc(v1[0], v1[1], v1[2], v1[3]);
                    } else *(u32x4*)(rp + bj * 128) = w;
                    if (colt < 1024) { const int rq68 = row / 68, rm68 = row - rq68 * 68; if (rm68 == 0 || rm68 == 67) *(u32x4*)(HALO + ((size_t)rq68 * 2 + (rm68 ? 1 : 0)) * 1024 + colt + bj * 128 + wc * 32 + 8 * fq) = w; } } }
    }
};
struct EpiMerge { static constexpr int HOOK_T = 4; static constexpr bool PERM = false; const unsigned char* PG; bf16_t* H; int row0; float* PP;
    DI void mid(AccT& acc, const Unit& u, int br, int wr, int wc, int fr, int fq) const {
        const unsigned char* gp = PG + ((size_t)u.pm * 16 + br * 4 + u.pn) * 65536 + (wr * 4 + wc) * 512 + (fr + 16 * fq) * 8;
        {
                u32x2 fn[8][2], fo[8][2];
#pragma unroll
                for (int mm = 0; mm < 8; ++mm)
#pragma unroll
                    for (int bj = 0; bj < 2; ++bj) { const int o = (mm * 2 + bj) * 4096; fn[mm][bj] = *(const u32x2*)(gp + o); fo[mm][bj] = *(const u32x2*)(gp + o - 4 * 65536); }
                asm volatile("" ::: "memory");
#pragma unroll
                for (int mm = 0; mm < 8; ++mm)
#pragma unroll
                    for (int bj = 0; bj < 2; ++bj) {
                        { const f32x4 en = f8x4(fn[mm][bj].x), eo = f8x4(fo[mm][bj].x);
#pragma unroll
                          for (int q = 0; q < 4; ++q) acc[mm >> 2][bj][mm & 3][0][q] *= en[q] * rcpf_(eo[q]); }
                        __builtin_amdgcn_sched_barrier(0);
                        { const f32x4 en = f8x4(fn[mm][bj].y), eo = f8x4(fo[mm][bj].y);
#pragma unroll
                          for (int q = 0; q < 4; ++q) acc[mm >> 2][bj][mm & 3][1][q] *= en[q] * rcpf_(eo[q]); }
                        __builtin_amdgcn_sched_barrier(0); }
            }
    }
    DI void operator()(const AccT& acc, const Unit& u, int wr, int wc, int fr, int fq) const {
        if (u.aux >= 8) {
            const int br = u.aux & 3;
            const unsigned char* gq = PG + ((size_t)u.pm * 16 + br * 4 + u.pn) * 65536 + (wr * 4 + wc) * 512 + (fr + 16 * fq) * 8;
            float* pp = PP + (size_t)((u.aux >> 4) * 4 + br) * 65536 + (wr * 4 + wc) * 512 + (fr + 16 * fq) * 8;
#pragma unroll
            for (int ai = 0; ai < 2; ++ai)
#pragma unroll
                for (int m = 0; m < 4; ++m) {
                    u32x2 f[2];
#pragma unroll
                    for (int bj = 0; bj < 2; ++bj) f[bj] = *(const u32x2*)(gq + ((ai * 4 + m) * 2 + bj) * 4096);
                    asm volatile("" ::: "memory");
#pragma unroll
                    for (int bj = 0; bj < 2; ++bj)
#pragma unroll
                        for (int n = 0; n < 2; ++n) { const f32x4 e = f8x4(n ? f[bj].y : f[bj].x) * 64.f; const f32x4 a = acc[ai][bj][m][n];
                            *(f32x4*)(pp + ((ai * 4 + m) * 2 + bj) * 4096 + 4 * n) = (f32x4){a[0] * rcpf_(e[0]), a[1] * rcpf_(e[1]), a[2] * rcpf_(e[2]), a[3] * rcpf_(e[3])}; }
                }
            return;
        }
        const unsigned char* gp = PG + ((size_t)u.pm * 16 + 3 * 4 + u.pn) * 65536 + (wr * 4 + wc) * 512 + (fr + 16 * fq) * 8;
        {
                u32x2 f[8][2];
#pragma unroll
                for (int mm = 0; mm < 8; ++mm)
#pragma unroll
                    for (int bj = 0; bj < 2; ++bj) f[mm][bj] = *(const u32x2*)(gp + (mm * 2 + bj) * 4096);
                asm volatile("" ::: "memory");
#pragma unroll
                for (int mm = 0; mm < 8; ++mm) { const int ai = mm >> 2, m = mm & 3, row = u.pm * 256 + ai * 128 + wr * 64 + m * 16 + fr; unsigned char* yp = (unsigned char*)H + (size_t)(row0 + row) * D + u.pn * 256 + wc * 32 + 4 * fq;
#pragma unroll
                    for (int bj = 0; bj < 2; ++bj)
#pragma unroll
                        for (int n = 0; n < 2; ++n) { const f32x4 e = f8x4(n ? f[mm][bj].y : f[mm][bj].x) * 64.f; const f32x4 a = acc[ai][bj][m][n];
                            *(unsigned*)(yp + bj * 128 + n * 16) = pk_fp8x4(a[0] * rcpf_(e[0]), a[1] * rcpf_(e[1]), a[2] * rcpf_(e[2]), a[3] * rcpf_(e[3])); } }
            }
    }
};
struct EpiOut { static constexpr int HOOK_T = 0; static constexpr bool PERM = false; const float* xin; const float* cin; bf16_t* XS; const float* modl; int l;
    DI void operator()(AccT& acc, const Unit& u, int wr, int wc, int fr, int fq) const {
        const int b = u.pm / 17, tb = u.pm % 17; const bool isctx = tb == 0;
        const float* ga = modl + (size_t)(isctx ? 8 : b) * 6144 + 2048 + u.pn * 256 + wc * 32 + 4 * fq;
        f32x4 gv[2][2];
#pragma unroll
        for (int bj = 0; bj < 2; ++bj)
#pragma unroll
            for (int n = 0; n < 2; ++n) gv[bj][n] = ld4(ga + bj * 128 + n * 16);
#pragma unroll
        for (int ai = 0; ai < 2; ++ai)
#pragma unroll
            for (int bj = 0; bj < 2; ++bj)
#pragma unroll
                for (int m = 0; m < 4; ++m)
#pragma unroll
                    for (int n = 0; n < 2; ++n) acc[ai][bj][m][n] *= gv[bj][n];
        asm volatile("" ::: "memory");
        const int lo = (wr * 64 + fr) * D + wc * 32 + 4 * fq;
        bf16_t* db = XS + (size_t)u.pm * 256 * D + u.pn * 256;
        if (l == 0) {
            const size_t tro = (isctx ? (size_t)b * CTX : (size_t)b * SEQ + (tb - 1) * 256) * D + u.pn * 256;
            const float* sb = (isctx ? cin : xin) + tro;
            f32x4 rv[2][2][2];
#pragma unroll
            for (int bj = 0; bj < 2; ++bj)
#pragma unroll
                for (int n = 0; n < 2; ++n) rv[0][bj][n] = ld4(sb + lo + bj * 128 + n * 16);
#pragma unroll
            for (int k = 0; k < 8; ++k) {
                if (k + 1 < 8) {
#pragma unroll
                    for (int bj = 0; bj < 2; ++bj)
#pragma unroll
                        for (int n = 0; n < 2; ++n) rv[(k + 1) & 1][bj][n] = ld4(sb + lo + (((k + 1) >> 2) * 128 + ((k + 1) & 3) * 16) * D + bj * 128 + n * 16); }
                asm volatile("" ::: "memory");
#pragma unroll
                for (int bj = 0; bj < 2; ++bj)
#pragma unroll
                    for (int n = 0; n < 2; ++n) { const f32x4 y = rv[k & 1][bj][n] + acc[k >> 2][bj][k & 3][n]; u32x2 w_; w_.x = pk2(y[0], y[1]); w_.y = pk2(y[2], y[3]);
                        *(u32x2*)(db + lo + ((k >> 2) * 128 + (k & 3) * 16) * D + bj * 128 + n * 16) = w_; }
                asm volatile("" ::: "memory");
            }
        } else {
            u32x2 rb[2][2][2];
#pragma unroll
            for (int bj = 0; bj < 2; ++bj)
#pragma unroll
                for (int n = 0; n < 2; ++n) rb[0][bj][n] = *(const u32x2*)(db + lo + bj * 128 + n * 16);
#pragma unroll
            for (int k = 0; k < 8; ++k) {
                if (k + 1 < 8) {
#pragma unroll
                    for (int bj = 0; bj < 2; ++bj)
#pragma unroll
                        for (int n = 0; n < 2; ++n) rb[(k + 1) & 1][bj][n] = *(const u32x2*)(db + lo + (((k + 1) >> 2) * 128 + ((k + 1) & 3) * 16) * D + bj * 128 + n * 16); }
                asm volatile("" ::: "memory");
#pragma unroll
                for (int bj = 0; bj < 2; ++bj)
#pragma unroll
                    for (int n = 0; n < 2; ++n) { const f32x4 y = bf4(rb[k & 1][bj][n]) + acc[k >> 2][bj][k & 3][n]; u32x2 w_; w_.x = pk2(y[0], y[1]); w_.y = pk2(y[2], y[3]);
                        *(u32x2*)(db + lo + ((k >> 2) * 128 + (k & 3) * 16) * D + bj * 128 + n * 16) = w_; }
                asm volatile("" ::: "memory");
            }
        }
    }
};
struct EpiGate { static constexpr int HOOK_T = 0; static constexpr bool PERM = true; bf16_t* PG;
    DI void operator()(const AccT& acc, const Unit& u, int wr, int wc, int fr, int fq) const {
#pragma unroll
        for (int ai = 0; ai < 2; ++ai)
#pragma unroll
            for (int m = 0; m < 4; ++m) { const int row = u.pm * 256 + ai * 128 + wr * 64 + m * 16 + fr; bf16_t* rp = PG + (size_t)row * NPG + u.pn * 256 + wc * 32 + 8 * fq;
#pragma unroll
                for (int bj = 0; bj < 2; ++bj) { float e[8];
#pragma unroll
                    for (int q = 0; q < 4; ++q) { e[q] = 1.f + __expf(-fminf(fmaxf(acc[ai][bj][m][0][q], -10.f), 10.f)); e[4 + q] = 1.f + __expf(-fminf(fmaxf(acc[ai][bj][m][1][q], -10.f), 10.f)); }
                    u32x4 w; w.x = pk2(e[0], e[1]); w.y = pk2(e[2], e[3]); w.z = pk2(e[4], e[5]); w.w = pk2(e[6], e[7]); *(u32x4*)(rp + bj * 128) = w; } }
    }
};
struct EpiUp { static constexpr int HOOK_T = 0; static constexpr bool PERM = true; unsigned char* hmid;
    DI void operator()(const AccT& acc, const Unit& u, int wr, int wc, int fr, int fq) const {
#pragma unroll
        for (int ai = 0; ai < 2; ++ai)
#pragma unroll
            for (int m = 0; m < 4; ++m) { const int row = u.pm * 256 + ai * 128 + wr * 64 + m * 16 + fr;
                float o[8];
#pragma unroll
                for (int n = 0; n < 2; ++n)
#pragma unroll
                    for (int j = 0; j < 4; ++j) o[n * 4 + j] = siluf_(acc[ai][0][m][n][j]) * acc[ai][1][m][n][j];
                u32x2 w; w.x = pk_fp8x4(o[0], o[1], o[2], o[3]); w.y = pk_fp8x4(o[4], o[5], o[6], o[7]);
                *(u32x2*)(hmid + (size_t)row * 512 + u.aux * 128 + wc * 32 + 8 * fq) = w; }
    }
};
struct EpiDown { static constexpr int HOOK_T = 0; static constexpr bool PERM = true; unsigned char* ys;
    DI void operator()(const AccT& acc, const Unit& u, int wr, int wc, int fr, int fq) const {
#pragma unroll
        for (int ai = 0; ai < 2; ++ai)
#pragma unroll
            for (int m = 0; m < 4; ++m) { const int row = u.pm * 256 + ai * 128 + wr * 64 + m * 16 + fr; unsigned char* rp = ys + (size_t)row * 1024 + u.aux * 256 + wc * 32 + 8 * fq;
#pragma unroll
                for (int bj = 0; bj < 2; ++bj) { const f32x4 v0 = acc[ai][bj][m][0] * 16.f, v1 = acc[ai][bj][m][1] * 16.f; u32x2 w; w.x = pk_fp8x4(v0[0], v0[1], v0[2], v0[3]); w.y = pk_fp8x4(v1[0], v1[1], v1[2], v1[3]); *(u32x2*)(rp + bj * 128) = w; } }
    }
};


DI int qpop(const int tid, unsigned* ctr, LAS int* slot) {
    __syncthreads();
    if (tid == 0) *slot = (int)__hip_atomic_fetch_add(ctr, 1u, __ATOMIC_RELAXED, __HIP_MEMORY_SCOPE_AGENT);
    __syncthreads();
    return __builtin_amdgcn_readfirstlane(*slot);
}
template <int QM>
DI void q_prep(const Ctx& X, int l, bf16x8 (&qf)[4], int h, bool isctx, int t) {
    float x[4][8];
#pragma unroll
    for (int s = 0; s < 4; ++s) { const u32x4 v = __builtin_bit_cast(u32x4, qf[s]);
#pragma unroll
        for (int j = 0; j < 4; ++j) { x[s][2 * j] = bflo(v[j]); x[s][2 * j + 1] = bfhi(v[j]); } }
    if (QM == 0) {
        float ss = 0.f;
#pragma unroll
        for (int s = 0; s < 4; ++s)
#pragma unroll
            for (int j = 0; j < 8; ++j) ss += x[s][j] * x[s][j];
        ss += __shfl_xor(ss, 32);
        const float rr = rsqrtf(ss * (1.f / 64.f) + EPS);
        const float* gw = X.kp->in[I_QNORM] + l * 64 + 8 * h;
#pragma unroll
        for (int s = 0; s < 4; ++s) { const f32x4 w0 = ld4(gw + 16 * s), w1 = ld4(gw + 16 * s + 4);
#pragma unroll
            for (int j = 0; j < 4; ++j) { x[s][j] = x[s][j] * rr * w0[j]; x[s][4 + j] = x[s][4 + j] * rr * w1[j]; } }
    }
    if (QM <= 1 && !isctx) {
        const float* rope = (const float*)(X.ws + OFF_rope);
#pragma unroll
        for (int s = 0; s < 4; ++s) { const int pos = s < 2 ? (t >> 6) : (t & 63); const float* rp = rope + (pos * 16 + (s & 1) * 8 + 4 * h) * 2;
            const f32x4 c0 = ld4(rp), c1 = ld4(rp + 4);
#pragma unroll
            for (int jj = 0; jj < 4; ++jj) { const float cs = jj < 2 ? c0[2 * jj] : c1[2 * (jj - 2)], sn = jj < 2 ? c0[2 * jj + 1] : c1[2 * (jj - 2) + 1];
                const float y0 = x[s][2 * jj] * cs - x[s][2 * jj + 1] * sn, y1 = x[s][2 * jj] * sn + x[s][2 * jj + 1] * cs; x[s][2 * jj] = y0; x[s][2 * jj + 1] = y1; } }
    }
#pragma unroll
    for (int s = 0; s < 4; ++s) { u32x4 v;
#pragma unroll
        for (int j = 0; j < 4; ++j) v[j] = pk2(x[s][2 * j] * (0.125f * 1.4426950408889634f), x[s][2 * j + 1] * (0.125f * 1.4426950408889634f));
        qf[s] = __builtin_bit_cast(bf16x8, v); }
}
DI int clampi(int v, int lo, int hi) { return v < lo ? lo : (v > hi ? hi : v); }
DI float bfe(const u32x4& v, int j) { return (j & 1) ? bfhi(v[j >> 1]) : bflo(v[j >> 1]); }

struct NbrLane { int kb0; unsigned tb, nb; int r0; };
template <int TYPE>
DI void attn_x1(const LAS unsigned char* Ks, const LAS float* biasL, const int ti, const int loc0, const int c0, const int tq, const int qr, const int qc, const int r, const int h,
                const int vb, const bf16x8 (&qf)[4], f32x16& s0, f32x16& s1, float& mx, s16x4 (&vl)[2][2][2], s16x4 (&vh)[2][2][2], const NbrLane& nl) {
    const bool local = ti >= 4; const int lt = loc0 + ti - 4;
    if (TYPE == 2 && local) {
#pragma unroll
        for (int i = 0; i < 16; ++i) s0[i] = 0.f;
#pragma unroll
        for (int s = 0; s < 4; ++s) { const bf16x8 a0 = *(const LAS bf16x8*)(Ks + (nl.kb0 + r) * 144 + 32 * s + 16 * h); s0 = mfma32(a0, qf[s], s0); }
        const int vbh = vb + nl.kb0 * 192;
#pragma unroll
        for (int s2 = 0; s2 < 2; ++s2)
#pragma unroll
            for (int dt = 0; dt < 2; ++dt) {
                asm volatile("ds_read_b64_tr_b16 %0, %1 offset:%2" : "=&v"(vl[0][s2][dt]) : "v"(vbh), "i"((16 * s2) * 192 + 64 * dt) : "memory");
                asm volatile("ds_read_b64_tr_b16 %0, %1 offset:%2" : "=&v"(vh[0][s2][dt]) : "v"(vbh), "i"((16 * s2 + 8) * 192 + 64 * dt) : "memory");
            }
        const int dr = lt - qr + 7; const bool rv = lt >= nl.r0 && lt < nl.r0 + 8;
        const LAS unsigned char* ba = (const LAS unsigned char*)(size_t)(rv ? nl.tb + (unsigned)(dr * 4096) : nl.nb);
        mx = -1.0e30f;
#pragma unroll
        for (int i = 0; i < 16; ++i) { s0[i] += *(const LAS float*)(ba + ((i & 3) + 8 * (i >> 2)) * 4); mx = fmaxf(mx, s0[i]); }
        mx = fmaxf(mx, __shfl_xor(mx, 32));
        return;
    }
#pragma unroll
    for (int i = 0; i < 16; ++i) { s0[i] = 0.f; s1[i] = 0.f; }
#pragma unroll
    for (int s = 0; s < 4; ++s) {
        const bf16x8 a0 = *(const LAS bf16x8*)(Ks + r * 144 + 32 * s + 16 * h), a1 = *(const LAS bf16x8*)(Ks + (32 + r) * 144 + 32 * s + 16 * h);
        s0 = mfma32(a0, qf[s], s0); s1 = mfma32(a1, qf[s], s1);
    }
#pragma unroll
    for (int kt = 0; kt < 2; ++kt)
#pragma unroll
        for (int s2 = 0; s2 < 2; ++s2)
#pragma unroll
            for (int dt = 0; dt < 2; ++dt) {
                asm volatile("ds_read_b64_tr_b16 %0, %1 offset:%2" : "=&v"(vl[kt][s2][dt]) : "v"(vb), "i"((32 * kt + 16 * s2) * 192 + 64 * dt) : "memory");
                asm volatile("ds_read_b64_tr_b16 %0, %1 offset:%2" : "=&v"(vh[kt][s2][dt]) : "v"(vb), "i"((32 * kt + 16 * s2 + 8) * 192 + 64 * dt) : "memory");
            }
    mx = -1.0e30f;
#pragma unroll
    for (int i = 0; i < 16; ++i) {
#pragma unroll
        for (int kt = 0; kt < 2; ++kt) {
            float s = kt ? s1[i] : s0[i];
            const int kidx = 32 * kt + (i & 3) + 8 * (i >> 2) + 4 * h;
            if (TYPE == 1 && local) { const int dlt = tq - (64 * lt + kidx); if (dlt > 128 || dlt < -128) s = -1.0e30f; }
            if (kt) s1[i] = s; else s0[i] = s;
            mx = fmaxf(mx, s);
        }
    }
    mx = fmaxf(mx, __shfl_xor(mx, 32));
}
template <bool HALF = false>
DI void attn_x2(f32x16& s0, f32x16& s1, const float mx, s16x4 (&vl)[2][2][2], s16x4 (&vh)[2][2][2], f32x16& ot0, f32x16& ot1, float& m_run, float& l_run) {
    if (!__all(mx <= m_run + 8.f)) {
        const float m_new = fmaxf(m_run, mx), alpha = __builtin_amdgcn_exp2f(m_run - m_new); m_run = m_new; l_run *= alpha;
#pragma unroll
        for (int i = 0; i < 16; ++i) { ot0[i] *= alpha; ot1[i] *= alpha; }
    }
    float ls = 0.f;
#pragma unroll
    for (int kt = 0; kt < (HALF ? 1 : 2); ++kt)
#pragma unroll
        for (int s2 = 0; s2 < 2; ++s2) {
            float p[8];
#pragma unroll
            for (int j = 0; j < 8; ++j) { p[j] = __builtin_amdgcn_exp2f((kt ? s1[8 * s2 + j] : s0[8 * s2 + j]) - m_run); ls += p[j]; }
            const bf16x8 pb = pack8(p[0], p[1], p[2], p[3], p[4], p[5], p[6], p[7]);
            ot0 = mfma32(__builtin_shufflevector(vl[kt][s2][0], vh[kt][s2][0], 0, 1, 2, 3, 4, 5, 6, 7), pb, ot0);
            ot1 = mfma32(__builtin_shufflevector(vl[kt][s2][1], vh[kt][s2][1], 0, 1, 2, 3, 4, 5, 6, 7), pb, ot1);
        }
    l_run += ls;
}

template <int TYPE>
DI void attn_item(const Ctx& X, int l, int item, bool ctxq) {
    const int tid = X.tid, lane = X.lane, wv = X.wv, r = lane & 31, h = lane >> 5;
    LAS unsigned char* KV = X.lds;
    LAS float* biasL = (LAS float*)(X.lds + 64512);
    const bf16_t* PA = (const bf16_t*)(X.ws + uo_projA(X.rs)); bf16_t* bc = (bf16_t*)(X.ws + uo_bcat(X.rs));
    int bl, head, kvh, tq, qr = 0, qc = 0, grp = 0, qt = 0;
    if (TYPE <= 1) { const int nq = ctxq ? 4 : 64; bl = item / (2 * nq); kvh = (item / nq) & 1; qt = item % nq; head = 4 * kvh + (wv >> 1); tq = qt * 64 + (wv & 1) * 32 + r; }
    else if (ctxq) { bl = item >> 3; head = item & 7; kvh = head; tq = wv * 32 + r; }
    else { bl = item >> 7; head = (item >> 4) & 7; kvh = head; grp = item & 15; qr = 4 * grp + 2 * (wv >> 2) + (r >> 4); qc = (wv & 3) * 16 + (r & 15); tq = qr * 64 + qc; }
    const int qcol = (TYPE == 0 ? C_GQ : TYPE == 1 ? C_WQ : C_NQ) + 64 * head, kcol = (TYPE == 0 ? C_GK : TYPE == 1 ? C_WK : C_NK) + 64 * kvh, vcol = (TYPE == 0 ? C_GV : TYPE == 1 ? C_WV : C_NV) + 64 * kvh;
    const int brow = bl * TPB, qrow = brow + (ctxq ? 0 : CTX) + tq;
    int nloc = 0, loc0 = 0;
    if (!ctxq) {
        if (TYPE == 0) { nloc = 64; }
        else if (TYPE == 1) { loc0 = qt - 2 < 0 ? 0 : qt - 2; nloc = (qt + 2 > 63 ? 63 : qt + 2) - loc0 + 1; }
        else { loc0 = clampi(4 * grp - 4, 0, 56); nloc = clampi(4 * grp - 1, 0, 56) + 7 - loc0 + 1; }
    }
    const int ntiles = 4 + nloc;
    const int c0 = clampi(qc - 8, 0, 48);
    const int qrA = 4 * grp + 2 * (wv >> 2), r0a = clampi(qrA - 4, 0, 56), r0b = clampi(qrA - 3, 0, 56);
    NbrLane nl = {0, 0u, 0u, 0};
    if (TYPE == 2 && !ctxq) {
        const float* rb = X.kp->in[I_RELB] + (size_t)(l * 8 + head) * 465;
        LAS float* rbl = biasL + 241 * 64;
        if (tid < 465) rbl[tid] = rb[tid] * 1.4426950408889634f;
        __syncthreads();
        for (int i = tid; i < 241 * 64; i += NTHR) { const int w = i & 63, row = i >> 6; float v = -1.0e30f;
            if (row < 240) { const int dr = row >> 4, sh = (row & 15) - 7, rel = w - 16; if (rel >= 7 + sh && rel < 23 + sh) v = rbl[dr * 31 + rel]; }
            biasL[i] = v; }
        const int j = wv & 3; nl.kb0 = j == 0 ? 0 : (j == 1 ? 8 : (j == 2 ? 24 : 32)); nl.r0 = clampi(qr - 4, 0, 56);
        const int sh = c0 - (qc - 8) + 7, colw = nl.kb0 - qc + 15 + 16 + 4 * h;
        nl.tb = (unsigned)(size_t)biasL + (unsigned)((sh * 64 + colw) * 4); nl.nb = (unsigned)(size_t)biasL + (unsigned)((240 * 64 + colw) * 4);
    }
    bf16x8 qf[4];
#pragma unroll
    for (int s = 0; s < 4; ++s) qf[s] = *(const bf16x8*)(PA + (size_t)qrow * NPA + qcol + 16 * s + 8 * h);
    q_prep<TYPE>(X, l, qf, h, ctxq, tq);
    f32x16 ot0, ot1;
#pragma unroll
    for (int i = 0; i < 16; ++i) { ot0[i] = 0.f; ot1[i] = 0.f; }
    float m_run = -1.0e30f, l_run = 0.f;
    if (TYPE == 1) { m_run = X.kp->in[I_SINK][l * 8 + head] * 1.4426950408889634f; l_run = h == 0 ? 1.f : 0.f; }
    int tidk = tid; asm volatile("" : "+v"(tidk)); const int skey = tidk >> 3, sdp = tidk & 7;
    const unsigned vb0 = (unsigned)(size_t)KV + 9216u + (unsigned)((4 * h + ((lane & 15) >> 2)) * 192 + (16 * ((lane >> 4) & 1) + 4 * (lane & 3)) * 2);
    u32x4 kregA, vregA, kregB, vregB, kregC, vregC;
#define ATT_LOAD(tn, kreg, vreg) do { const int trow_ = brow + ((tn) < 4 ? 64 * (tn) : CTX + 64 * (loc0 + (tn) - 4)); const size_t ro_ = (size_t)(trow_ + skey) * NPA + sdp * 8; \
        kreg = *(const u32x4*)(PA + ro_ + kcol); vreg = *(const u32x4*)(PA + ro_ + vcol); } while (0)
#define ATT_STORE(buf, kreg, vreg) do { LAS unsigned char* Ks_ = KV + (buf) * 21504; *(LAS u32x4*)(Ks_ + skey * 144 + sdp * 16) = kreg; *(LAS u32x4*)(Ks_ + 9216 + skey * 192 + sdp * 16) = vreg; } while (0)
#define ATT_BARRIER() do { asm volatile("s_waitcnt lgkmcnt(0)" ::: "memory"); __builtin_amdgcn_s_barrier(); asm volatile("" ::: "memory"); } while (0)
    ATT_LOAD(0, kregA, vregA); ATT_LOAD(1, kregB, vregB); ATT_LOAD(2, kregC, vregC);
    ATT_STORE(0, kregA, vregA);
    ATT_LOAD(3, kregA, vregA);
    ATT_BARRIER();
    f32x16 s0, s1; float mx = 0.f; s16x4 vl[2][2][2], vh[2][2][2];
    int bcur = 0;
#define ATT_ACTIVE(t) (!(TYPE == 2 && (t) >= 4) || ((loc0 + (t) - 4 >= r0a) && (loc0 + (t) - 4 < r0b + 8)))
#define ATT_TILE(ti, kreg, vreg) do { const int bn_ = bcur == 2 ? 0 : bcur + 1; \
        if ((ti) + 1 < ntiles) ATT_STORE(bn_, kreg, vreg); \
        if ((ti) + 4 < ntiles) ATT_LOAD((ti) + 4, kreg, vreg); \
        const bool act_ = ATT_ACTIVE(ti); \
        if (act_) attn_x1<TYPE>(KV + bcur * 21504, biasL, (ti), loc0, c0, tq, qr, qc, r, h, (int)(vb0 + (unsigned)(bcur * 21504)), qf, s0, s1, mx, vl, vh, nl); \
        if (TYPE == 2 && (ti) >= 4) { asm volatile("s_waitcnt lgkmcnt(0)" ::: "memory"); __builtin_amdgcn_sched_barrier(0); } else ATT_BARRIER();        \
        if (act_) { if (TYPE == 2 && (ti) >= 4) attn_x2<true>(s0, s1, mx, vl, vh, ot0, ot1, m_run, l_run); else attn_x2<false>(s0, s1, mx, vl, vh, ot0, ot1, m_run, l_run); } \
        ATT_BARRIER(); bcur = bn_; } while (0)
    for (int ti = 0; ti < ntiles; ti += 3) {
        ATT_TILE(ti, kregB, vregB);
        if (ti + 1 < ntiles) ATT_TILE(ti + 1, kregC, vregC);
        if (ti + 2 < ntiles) ATT_TILE(ti + 2, kregA, vregA);
    }
#undef ATT_ACTIVE
#undef ATT_TILE
#undef ATT_LOAD
#undef ATT_STORE
#undef ATT_BARRIER
    const float inv = rcpf_(l_run + __shfl_xor(l_run, 32));
    unsigned char* op = (unsigned char*)bc + (size_t)qrow * 2048 + 512 * (TYPE + 1) + 64 * head + 4 * h;
#pragma unroll
    for (int g4 = 0; g4 < 4; ++g4) {
        *(unsigned*)(op + 8 * g4) = pk_fp8x4(ot0[4 * g4] * inv, ot0[4 * g4 + 1] * inv, ot0[4 * g4 + 2] * inv, ot0[4 * g4 + 3] * inv);
        *(unsigned*)(op + 32 + 8 * g4) = pk_fp8x4(ot1[4 * g4] * inv, ot1[4 * g4 + 1] * inv, ot1[4 * g4 + 2] * inv, ot1[4 * g4 + 3] * inv);
    }
}

DI void g64_tile(const LAS unsigned char* Ks, const LAS unsigned char* Qw, const int r, const int h, const int vb, f32x16 (&ot)[2][2], float (&m_run)[2], float (&l_run)[2], const bool first) {
    f32x16 sc[2][2];
#pragma unroll
    for (int g = 0; g < 2; ++g)
#pragma unroll
        for (int i = 0; i < 16; ++i) { sc[g][0][i] = 0.f; sc[g][1][i] = 0.f; }
#pragma unroll
    for (int s = 0; s < 4; ++s) {
        const bf16x8 a0 = *(const LAS bf16x8*)(Ks + r * 144 + 32 * s + 16 * h), a1 = *(const LAS bf16x8*)(Ks + (32 + r) * 144 + 32 * s + 16 * h);
#pragma unroll
        for (int g = 0; g < 2; ++g) { const bf16x8 qv = *(const LAS bf16x8*)(Qw + (32 * g + r) * 144 + 32 * s + 16 * h); sc[g][0] = mfma32(a0, qv, sc[g][0]); sc[g][1] = mfma32(a1, qv, sc[g][1]); }
    }
    s16x4 vl[2][2], vh[2][2];
#define G64_TR(kt) do { _Pragma("unroll") for (int s2 = 0; s2 < 2; ++s2) _Pragma("unroll") for (int dt = 0; dt < 2; ++dt) { \
        asm volatile("ds_read_b64_tr_b16 %0, %1 offset:%2" : "=&v"(vl[s2][dt]) : "v"(vb), "i"((32 * (kt) + 16 * s2) * 192 + 64 * dt) : "memory"); \
        asm volatile("ds_read_b64_tr_b16 %0, %1 offset:%2" : "=&v"(vh[s2][dt]) : "v"(vb), "i"((32 * (kt) + 16 * s2 + 8) * 192 + 64 * dt) : "memory"); } } while (0)
    G64_TR(0);
#pragma unroll
    for (int g = 0; g < 2; ++g) {
        const float mm = m_run[g];
        float mxa = -3.0e38f, mxb = -3.0e38f;
#pragma unroll
        for (int kt = 0; kt < 2; ++kt)
#pragma unroll
            for (int jj = 0; jj < 8; ++jj) { const float t0 = sc[g][kt][2 * jj] - mm, t1 = sc[g][kt][2 * jj + 1] - mm; if (jj & 1) mxb = fmaxf(fmaxf(mxb, t0), t1); else mxa = fmaxf(fmaxf(mxa, t0), t1); sc[g][kt][2 * jj] = t0; sc[g][kt][2 * jj + 1] = t1; }
        float mx = fmaxf(mxa, mxb); mx = fmaxf(mx, __shfl_xor(mx, 32));
        if (first || !__all(mx <= 8.f)) {
            const float d = first ? mx : fmaxf(mx, 0.f), alpha = first ? 1.f : __builtin_amdgcn_exp2f(-d); m_run[g] += d; l_run[g] *= alpha;
#pragma unroll
            for (int i = 0; i < 16; ++i) { ot[g][0][i] *= alpha; ot[g][1][i] *= alpha; sc[g][0][i] -= d; sc[g][1][i] -= d; }
        }
    }
    float ls[2] = {0.f, 0.f};
#pragma unroll
    for (int kt = 0; kt < 2; ++kt) {
        bf16x8 pb[2][2];
#pragma unroll
        for (int s2 = 0; s2 < 2; ++s2)
#pragma unroll
            for (int g = 0; g < 2; ++g) { float p[8];
#pragma unroll
                for (int j = 0; j < 8; ++j) { p[j] = __builtin_amdgcn_exp2f(sc[g][kt][8 * s2 + j]); ls[g] += p[j]; }
                pb[s2][g] = pack8(p[0], p[1], p[2], p[3], p[4], p[5], p[6], p[7]); }
        asm volatile("s_waitcnt lgkmcnt(0)" ::: "memory"); __builtin_amdgcn_sched_barrier(0);
        bf16x8 va[2][2];
#pragma unroll
        for (int s2 = 0; s2 < 2; ++s2)
#pragma unroll
            for (int dt = 0; dt < 2; ++dt) va[s2][dt] = __builtin_shufflevector(vl[s2][dt], vh[s2][dt], 0, 1, 2, 3, 4, 5, 6, 7);
        if (kt == 0) { asm volatile("" : "+v"(va[0][0]), "+v"(va[0][1]), "+v"(va[1][0]), "+v"(va[1][1])); G64_TR(1); }
#pragma unroll
        for (int s2 = 0; s2 < 2; ++s2)
#pragma unroll
            for (int g = 0; g < 2; ++g) { ot[g][0] = mfma32(va[s2][0], pb[s2][g], ot[g][0]); ot[g][1] = mfma32(va[s2][1], pb[s2][g], ot[g][1]); }
    }
#undef G64_TR
    l_run[0] += ls[0]; l_run[1] += ls[1];
}

DI void attn_global64(const Ctx& X, int l, int item) {
    const int tid = X.tid, lane = X.lane, wv = X.wv, r = lane & 31, h = lane >> 5;
    LAS unsigned char* KV = X.lds;
    LAS unsigned char* Qw = X.lds + 43008 + wv * 9216;
    const bf16_t* PA = (const bf16_t*)(X.ws + uo_projA(X.rs)); bf16_t* bc = (bf16_t*)(X.ws + uo_bcat(X.rs));
    const int bl = item >> 6, kvh = (item >> 5) & 1, qt = item & 31, head = 4 * kvh + (wv >> 1);
    const int brow = bl * TPB, qrow0 = brow + CTX + qt * 128 + (wv & 1) * 64 + r;
    const int qcol = C_GQ + 64 * head, kcol = C_GK + 64 * kvh, vcol = C_GV + 64 * kvh;
#pragma unroll 1
    for (int g = 0; g < 2; ++g) { bf16x8 qf[4];
#pragma unroll
        for (int s = 0; s < 4; ++s) qf[s] = *(const bf16x8*)(PA + (size_t)(qrow0 + 32 * g) * NPA + qcol + 16 * s + 8 * h);
        q_prep<0>(X, l, qf, h, false, qt * 128 + (wv & 1) * 64 + 32 * g + r);
#pragma unroll
        for (int s = 0; s < 4; ++s) *(LAS bf16x8*)(Qw + (32 * g + r) * 144 + 32 * s + 16 * h) = qf[s]; }
    f32x16 ot[2][2];
#pragma unroll
    for (int g = 0; g < 2; ++g)
#pragma unroll
        for (int i = 0; i < 16; ++i) { ot[g][0][i] = 0.f; ot[g][1][i] = 0.f; }
    float m_run[2] = {0.f, 0.f}, l_run[2] = {0.f, 0.f};
    int tidk = tid; asm volatile("" : "+v"(tidk)); const int skey = tidk >> 3, sdp = tidk & 7;
    const unsigned vb0 = (unsigned)(size_t)KV + 9216u + (unsigned)((4 * h + ((lane & 15) >> 2)) * 192 + (16 * ((lane >> 4) & 1) + 4 * (lane & 3)) * 2);
    u32x4 kregA, vregA, kregB, vregB;
#define ATT_LOAD(tn, kreg, vreg) do { const size_t ro_ = (size_t)(brow + 64 * (tn) + skey) * NPA + sdp * 8; kreg = *(const u32x4*)(PA + ro_ + kcol); vreg = *(const u32x4*)(PA + ro_ + vcol); } while (0)
#define ATT_STORE(buf, kreg, vreg) do { LAS unsigned char* Ks_ = KV + (buf) * 21504; *(LAS u32x4*)(Ks_ + skey * 144 + sdp * 16) = kreg; *(LAS u32x4*)(Ks_ + 9216 + skey * 192 + sdp * 16) = vreg; } while (0)
#define ATT_BARRIER() do { asm volatile("s_waitcnt lgkmcnt(0)" ::: "memory"); __builtin_amdgcn_s_barrier(); asm volatile("" ::: "memory"); } while (0)
    constexpr int ntiles = TPB / 64;
    ATT_LOAD(0, kregA, vregA); ATT_STORE(0, kregA, vregA);
    ATT_LOAD(1, kregA, vregA); ATT_LOAD(2, kregB, vregB);
    ATT_BARRIER();
#define ATT_TILE(ti, kreg, vreg) do { \
        if ((ti) + 1 < ntiles) ATT_STORE(((ti) + 1) & 1, kreg, vreg); \
        if ((ti) + 3 < ntiles) ATT_LOAD((ti) + 3, kreg, vreg); \
        g64_tile(KV + ((ti) & 1) * 21504, Qw, r, h, (int)(vb0 + (unsigned)(((ti) & 1) * 21504)), ot, m_run, l_run, (ti) == 0); \
        ATT_BARRIER(); } while (0)
    for (int ti = 0; ti < ntiles; ti += 2) { ATT_TILE(ti, kregA, vregA); ATT_TILE(ti + 1, kregB, vregB); }
#undef ATT_TILE
#undef ATT_LOAD
#undef ATT_STORE
#undef ATT_BARRIER
#pragma unroll
    for (int g = 0; g < 2; ++g) {
        const float inv = rcpf_(l_run[g] + __shfl_xor(l_run[g], 32));
        unsigned char* op = (unsigned char*)bc + (size_t)(qrow0 + 32 * g) * 2048 + 512 + 64 * head + 4 * h;
#pragma unroll
        for (int g4 = 0; g4 < 4; ++g4) {
            *(unsigned*)(op + 8 * g4) = pk_fp8x4(ot[g][0][4 * g4] * inv, ot[g][0][4 * g4 + 1] * inv, ot[g][0][4 * g4 + 2] * inv, ot[g][0][4 * g4 + 3] * inv);
            *(unsigned*)(op + 32 + 8 * g4) = pk_fp8x4(ot[g][1][4 * g4] * inv, ot[g][1][4 * g4 + 1] * inv, ot[g][1][4 * g4 + 2] * inv, ot[g][1][4 * g4 + 3] * inv);
        }
    }
}

DI void chain_item(const Ctx& X, int l, int bg0, int item) {
    const int tid = X.tid, lane = X.lane, wv = X.wv;
    const int bl = item >> 3, head = (item >> 1) & 3, dir = item & 1, b = bg0 + bl;
    LAS unsigned char* L = X.lds;
    constexpr int QS = 0, KS = 17408, KTS = 34816, VTS = 53248, CTS = 76288, SCU = 119808, SCM = SCU + 256, SCI = SCM + 256, SCF = SCI + 256;
    constexpr float LOG2E = 1.4426950408889634f;
    const bf16_t* PA = (const bf16_t*)(X.ws + uo_projA(X.rs)); bf16_t* hp = (bf16_t*)(X.ws + uo_hpart(X.rs));
    const float* gI = (const float*)(X.ws + OFF_gI); const float* gF = (const float*)(X.ws + OFF_gF);
    for (int i = tid; i < 43520 / 4; i += NTHR) ((LAS unsigned*)(L + CTS))[i] = 0u;
    for (int i = tid; i < 32 * 144 / 4; i += NTHR) ((LAS unsigned*)(L + VTS + 128 * 144))[i] = (i < 36) ? 0x3F803F80u : 0u;
    f32x16 ct0, ct1, ct2;
#pragma unroll
    for (int i = 0; i < 16; ++i) { ct0[i] = 0.f; ct1[i] = 0.f; ct2[i] = 0.f; }
    float m_run = -1.0e30f;
    u32x4 rq[2], rk[2], rv[2]; float ric, rfc;
    const unsigned loff0 = (unsigned)(tid >> 4) * (NPA * 2) + (unsigned)(tid & 15) * 16;
#define CHAIN_LOAD(stepn) do { const int seg_ = (stepn) >= 4 ? 1 : 0, cpo_ = seg_ ? (stepn) - 4 : (stepn), seglen_ = seg_ ? SEQ : CTX, segrow0_ = bl * TPB + (seg_ ? CTX : 0); \
        _Pragma("unroll") for (int it = 0; it < 2; ++it) { const int pp_ = cpo_ * 64 + (tid >> 4) + 32 * it, tk_ = dir ? seglen_ - 1 - pp_ : pp_; \
            const bf16_t* rp_ = PA + (size_t)(segrow0_ + tk_) * NPA + head * 128 + (tid & 15) * 8; \
            rq[it] = *(const u32x4*)(rp_ + C_MQ); rk[it] = *(const u32x4*)(rp_ + C_MK); rv[it] = *(const u32x4*)(rp_ + C_MV); } \
        { const int pp_ = cpo_ * 64 + lane, tk_ = dir ? seglen_ - 1 - pp_ : pp_, tt_ = (seg_ ? CTX : 0) + tk_; const size_t gi_ = ((size_t)(dir * NB + b) * 4 + head) * TPB + tt_; ric = gI[gi_]; rfc = gF[gi_]; } } while (0)
    (void)loff0;
#define CH_BARRIER() do { asm volatile("s_waitcnt lgkmcnt(0)" ::: "memory"); __builtin_amdgcn_s_barrier(); asm volatile("" ::: "memory"); } while (0)
    CHAIN_LOAD(0);
    __syncthreads();
    for (int step = 0; step < 68; ++step) {
        const int seg = step >= 4 ? 1 : 0, cpo = seg ? step - 4 : step, seglen = seg ? SEQ : CTX, segrow0 = bl * TPB + (seg ? CTX : 0);
        float decay, wgv;
        {
            const float bb = wave_scan<false>(rfc);
            const float u = ric - bb; const float pm = wave_scan<true>(u);
            const float Mv = fmaxf(pm, m_run), bend = lane_bcast(bb, 63), Mend = lane_bcast(Mv, 63);
            wgv = __expf(u - Mend); decay = __expf(m_run - Mend);
            if (wv == 0) { ((LAS float*)(L + SCU))[lane] = u * LOG2E; ((LAS float*)(L + SCM))[lane] = Mv * LOG2E; ((LAS float*)(L + SCI))[lane] = __expf(m_run - Mv); ((LAS float*)(L + SCF))[lane] = __expf(-(bb + Mv)); }
            m_run = bend + Mend;
        }
        {
            int tid_ = tid; asm volatile("" : "+v"(tid_)); const int sp0 = tid_ >> 4, sdp = tid_ & 15;
#pragma unroll
            for (int it = 0; it < 2; ++it) {
                const int p = sp0 + 32 * it;
                float wg;
                { const int pb = 4 * wv + 32 * it; const float a0 = lane_bcast(wgv, pb), a1 = lane_bcast(wgv, pb + 1), a2 = lane_bcast(wgv, pb + 2), a3 = lane_bcast(wgv, pb + 3);
                  const int rw_ = (tid_ >> 4) & 3; wg = rw_ == 0 ? a0 : rw_ == 1 ? a1 : rw_ == 2 ? a2 : a3; }
                *(LAS u32x4*)(L + QS + p * 272 + sdp * 16) = rq[it]; *(LAS u32x4*)(L + KS + p * 272 + sdp * 16) = rk[it];
                u32x4 ks; ks.x = pk2(bflo(rk[it].x) * wg, bfhi(rk[it].x) * wg); ks.y = pk2(bflo(rk[it].y) * wg, bfhi(rk[it].y) * wg); ks.z = pk2(bflo(rk[it].z) * wg, bfhi(rk[it].z) * wg); ks.w = pk2(bflo(rk[it].w) * wg, bfhi(rk[it].w) * wg);
                const u32x4 v1 = rv[it];
#pragma unroll
                for (int j = 0; j < 8; ++j) {
                    *(LAS bf16_t*)(L + KTS + (sdp * 8 + j) * 144 + ((p * 2) ^ ((sdp & 7) << 4))) = (bf16_t)((j & 1) ? (ks[j >> 1] >> 16) : (ks[j >> 1] & 0xffffu));
                    *(LAS bf16_t*)(L + VTS + (sdp * 8 + j) * 144 + ((p * 2) ^ ((sdp & 7) << 4))) = (bf16_t)((j & 1) ? (v1[j >> 1] >> 16) : (v1[j >> 1] & 0xffffu));
                }
            }
        }
        CH_BARRIER();
        if (step + 1 < 68) CHAIN_LOAD(step + 1);
        {
            int lane_ = lane; asm volatile("" : "+v"(lane_)); const int r = lane_ & 31, h = lane_ >> 5;
            const int j = wv & 1, i = wv >> 1, t = 32 * j + r;
            const float Mt = ((const LAS float*)(L + SCM))[t], itr = ((const LAS float*)(L + SCI))[t], fl = ((const LAS float*)(L + SCF))[t];
            const int vsw = (((32 * i + r) >> 3) & 7) << 4;
            bf16x8 qf[8];
#pragma unroll
            for (int ks = 0; ks < 8; ++ks) qf[ks] = *(const LAS bf16x8*)(L + QS + t * 272 + 32 * ks + 16 * h);
            f32x16 st, nt, et;
#pragma unroll
            for (int q = 0; q < 16; ++q) { st[q] = 0.f; nt[q] = 0.f; et[q] = 0.f; }
#pragma unroll
            for (int ks = 0; ks < 8; ++ks) {
                nt = mfma32(*(const LAS bf16x8*)(L + CTS + (32 * i + r) * 272 + 32 * ks + 16 * h), qf[ks], nt);
                st = mfma32(*(const LAS bf16x8*)(L + KS + r * 272 + 32 * ks + 16 * h), qf[ks], st);
                et = mfma32(*(const LAS bf16x8*)(L + CTS + (128 + r) * 272 + 32 * ks + 16 * h), qf[ks], et);
            }
            const float qn = sum_x32(et[0]);
#pragma unroll
            for (int q = 0; q < 16; ++q) nt[q] *= itr;
            float rsum = 0.f;
#pragma unroll
            for (int si = 0; si < 2; ++si) {
                if (si <= j) {
                    if (si == 1) {
#pragma unroll
                        for (int q = 0; q < 16; ++q) st[q] = 0.f;
#pragma unroll
                        for (int ks = 0; ks < 8; ++ks) st = mfma32(*(const LAS bf16x8*)(L + KS + (32 + r) * 272 + 32 * ks + 16 * h), qf[ks], st);
                    }
                    const bool diag = (si == j);
#pragma unroll
                    for (int g4 = 0; g4 < 4; ++g4) {
                        const f32x4 u0 = *(const LAS f32x4*)(L + SCU + (32 * si + 8 * g4 + 4 * h) * 4);
#pragma unroll
                        for (int q = 0; q < 4; ++q) { const int sa = 32 * si + 8 * g4 + 4 * h + q; float e0 = __builtin_amdgcn_exp2f(u0[q] - Mt); if (diag && sa > t) e0 = 0.f; st[4 * g4 + q] *= e0; rsum += st[4 * g4 + q]; }
                    }
#pragma unroll
                    for (int s2 = 0; s2 < 2; ++s2) {
                        const bf16x8 pb = pack8(st[8 * s2], st[8 * s2 + 1], st[8 * s2 + 2], st[8 * s2 + 3], st[8 * s2 + 4], st[8 * s2 + 5], st[8 * s2 + 6], st[8 * s2 + 7]);
                        const int ko = (32 * si + 16 * s2 + 4 * h) * 2;
                        const s16x4 lo = *(const LAS s16x4*)(L + VTS + (32 * i + r) * 144 + (ko ^ vsw)), hi = *(const LAS s16x4*)(L + VTS + (32 * i + r) * 144 + ((ko + 16) ^ vsw));
                        nt = mfma32(__builtin_shufflevector(lo, hi, 0, 1, 2, 3, 4, 5, 6, 7), pb, nt);
                    }
                }
            }
            rsum = sum_x32(rsum);
            const float den = rsum + itr * qn, inv = rcpf_(fmaxf(fabsf(den), fl));
            const int pp = cpo * 64 + t, tk = dir ? seglen - 1 - pp : pp;
            bf16_t* op = hp + ((size_t)dir * X.rs + segrow0 + tk) * 512 + head * 128 + 32 * i + 4 * h;
#pragma unroll
            for (int g4 = 0; g4 < 4; ++g4) { u32x2 w; w.x = pk2(nt[4 * g4] * inv, nt[4 * g4 + 1] * inv); w.y = pk2(nt[4 * g4 + 2] * inv, nt[4 * g4 + 3] * inv); *(u32x2*)(op + 8 * g4) = w; }
        }
        CH_BARRIER();
        {
            int lane_ = lane; asm volatile("" : "+v"(lane_)); const int r = lane_ & 31, h = lane_ >> 5;
            const int a = wv >> 1, c0 = 2 * (wv & 1); const bool own_n = (wv & 1) == 0;
#pragma unroll
            for (int q = 0; q < 16; ++q) { ct0[q] *= decay; ct1[q] *= decay; ct2[q] *= decay; }
            const int ksw = (((32 * a + r) >> 3) & 7) << 4, vs0 = (((32 * c0 + r) >> 3) & 7) << 4, vs1 = (((32 * (c0 + 1) + r) >> 3) & 7) << 4;
#pragma unroll
            for (int ss = 0; ss < 4; ++ss) {
                const bf16x8 ka = *(const LAS bf16x8*)(L + KTS + (32 * a + r) * 144 + ((32 * ss + 16 * h) ^ ksw));
                const bf16x8 v0 = *(const LAS bf16x8*)(L + VTS + (32 * c0 + r) * 144 + ((32 * ss + 16 * h) ^ vs0)), v1 = *(const LAS bf16x8*)(L + VTS + (32 * (c0 + 1) + r) * 144 + ((32 * ss + 16 * h) ^ vs1));
                ct0 = mfma32(ka, v0, ct0); ct1 = mfma32(ka, v1, ct1);
                if (own_n) { const bf16x8 v2 = *(const LAS bf16x8*)(L + VTS + (128 + r) * 144 + 32 * ss + 16 * h); ct2 = mfma32(ka, v2, ct2); }
            }
#pragma unroll
            for (int g4 = 0; g4 < 4; ++g4) {
                u32x2 w; w.x = pk2(ct0[4 * g4], ct0[4 * g4 + 1]); w.y = pk2(ct0[4 * g4 + 2], ct0[4 * g4 + 3]); *(LAS u32x2*)(L + CTS + (32 * c0 + r) * 272 + (32 * a + 8 * g4 + 4 * h) * 2) = w;
                w.x = pk2(ct1[4 * g4], ct1[4 * g4 + 1]); w.y = pk2(ct1[4 * g4 + 2], ct1[4 * g4 + 3]); *(LAS u32x2*)(L + CTS + (32 * (c0 + 1) + r) * 272 + (32 * a + 8 * g4 + 4 * h) * 2) = w;
                if (own_n) { w.x = pk2(ct2[4 * g4], ct2[4 * g4 + 1]); w.y = pk2(ct2[4 * g4 + 2], ct2[4 * g4 + 3]); *(LAS u32x2*)(L + CTS + (128 + r) * 272 + (32 * a + 8 * g4 + 4 * h) * 2) = w; }
            }
        }
        CH_BARRIER();
    }
#undef CHAIN_LOAD
#undef CH_BARRIER
}

DI void phase_mix(const Ctx& X, int l, int sp, const int qsel = 0, const int parts = 31) {
    unsigned* q = X.ctl + CW_QUEUE + 64 * ((l * 8 + sp + qsel) * 8);
    LAS int* slot = (LAS int*)(X.lds + MISC_OFF + 64);
    const int nbs = X.nbs;
    if (parts & 1) { const int n = nbs * 8; for (;;) { const int it = qpop(X.tid, q, slot); if (it >= n) break; chain_item(X, l, sp * nbs, it); } }
    if (parts & 2) { const int np = nbs * 2, nbig = np * 28, nsm = np * 8, n = nbig + nsm + (l == 0 ? nbs * 8 : 0);
        for (;;) { const int it = qpop(X.tid, q + 64, slot); if (it >= n) break;
            if (it < nbig) attn_global64(X, l, (it / 28) * 32 + it % 28);
            else if (it < nbig + nsm) { const int k = it - nbig; attn_item<0>(X, l, (k >> 3) * 64 + 56 + (k & 7), false); }
            else attn_item<0>(X, l, it - nbig - nsm, true); } }
    const int nd = (l == 0 && sp == 0) ? 120 : 0, lim0 = (l == 0) ? 64 : 160;
    const int ne = (X.nsplit == 2) ? (sp == 0 ? lim0 : 384 - lim0) : (sp == X.nsplit - 1 ? 384 : 0), eoff = (X.nsplit == 2 && sp == 1) ? lim0 : 0;
    const int nconv = nd + ne;
    bool conv = (parts & 16) && nconv > 0;
#define MIX_CONV_ONE() do { if (conv) { const int ic_ = qpop(X.tid, q + 320, slot); if (ic_ < nconv) { if (ic_ >= nd) { const int ie_ = eoff + ic_ - nd; convert_experts(X, l, ie_ * 16, ie_ * 16 + 16); } else convert_dense(X, 1152 + ic_ * 16, 1152 + ic_ * 16 + 16); } else conv = false; } } while (0)
#define MIX_SHORT_LOOP(TY, qoff) do { const int nl = nbs * 128, n = nl + (l == 0 ? nbs * 8 : 0); int it = qpop(X.tid, q + (qoff), slot); \
        while (it < n) { int nraw = 0; if (X.tid == 0) nraw = (int)__hip_atomic_fetch_add(q + (qoff), 1u, __ATOMIC_RELAXED, __HIP_MEMORY_SCOPE_AGENT); \
            attn_item<TY>(X, l, it < nl ? it : it - nl, it >= nl); MIX_CONV_ONE(); \
            __syncthreads(); if (X.tid == 0) *slot = nraw; __syncthreads(); it = __builtin_amdgcn_readfirstlane(*slot); } } while (0)
    if (parts & 4) MIX_SHORT_LOOP(2, 128);
    if (parts & 8) MIX_SHORT_LOOP(1, 192);
#undef MIX_SHORT_LOOP
    while (conv) MIX_CONV_ONE();
#undef MIX_CONV_ONE
    __syncthreads();
}

DI void phase_inp(const Ctx& X, int l, int sp) {
    pg8::Gemm8 g{X.ws + OFF_h8in + (size_t)sp * X.rs * D, X.ws + OFF_win8 + (size_t)l * NPROJ * D, 1024, 1024, 1024, 0x7C7C7C7C, 0x7C7C7C7C};
    TileSched S{X.rs / 256, NPROJ / 256, X.G, X.bid, 0};
    EpiProj E{(bf16_t*)(X.ws + uo_projA(X.rs)), (bf16_t*)(X.ws + uo_projG(X.rs)), (bf16_t*)(X.ws + OFF_halo)};
    pg8::gemm_phase8(X.lds, X.tid, g, S, E);
}
DI void phase_mrg(const Ctx& X, int l, int sp) {
    pg8::Gemm8 g{X.ws + uo_bcat(X.rs), X.ws + OFF_wbr + (size_t)l * 1024 * 2048, 2048, 2048, 2048, 0x7C7C7C7C, 0x7C7C7C7C};
    float* PP = (float*)(X.ws + uo_projA(X.rs));
    EpiMerge E{(const unsigned char*)(X.ws + uo_projG(X.rs)), (bf16_t*)(X.ws + OFF_h), sp * X.rs, PP};
    if (l != 0) { TileSched S{X.nbs * 16, 4, X.G, X.bid, 1}; pg8::gemm_phase8(X.lds, X.tid, g, S, E); return; }
    MrgSched0 S{X.nbs, X.G, X.bid};
    pg8::gemm_phase8(X.lds, X.tid, g, S, E);
    unsigned* cnt = X.ctl + CW_QUEUE + 64 * ((l * 8 + sp) * 8 + 6);
    LAS int* slot = (LAS int*)(X.lds + MISC_OFF + 64);
    const int nfull = X.nbs * 64, npart = X.nbs * 16;
    for (int i = 0;; ++i) {
        const int L = i * X.G + X.bid; if (L >= nfull + npart) break; if (L < nfull) continue;
        const int c4 = (L - nfull) >> 2;
        asm volatile("s_waitcnt vmcnt(0)" ::: "memory"); __syncthreads();
        if (X.tid == 0) { __builtin_amdgcn_fence(__ATOMIC_RELEASE, "agent"); asm volatile("s_waitcnt vmcnt(0)" ::: "memory");
            const int o_ = (int)__hip_atomic_fetch_add(cnt + c4, 1u, __ATOMIC_RELAXED, __HIP_MEMORY_SCOPE_AGENT);
            if (o_ == 3) { __builtin_amdgcn_fence(__ATOMIC_ACQUIRE, "agent"); asm volatile("s_waitcnt vmcnt(0)" ::: "memory"); }
            *slot = o_; }
        __syncthreads();
        const int old = __builtin_amdgcn_readfirstlane(*slot);
        if (old == 3) {
            const int wid = X.wv, lane = X.lane, wr = wid >> 2, wc = wid & 3, fr = lane & 15, fq = lane >> 4, pm = (c4 >> 2) * 17, pn = c4 & 3;
            const float* pp = PP + (size_t)(c4 * 4) * 65536 + wid * 512 + lane * 8;
#pragma unroll 1
            for (int am = 0; am < 8; ++am) {
                const int row = pm * 256 + (am >> 2) * 128 + wr * 64 + (am & 3) * 16 + fr; unsigned char* yp = (unsigned char*)E.H + (size_t)(sp * X.rs + row) * D + pn * 256 + wc * 32 + 4 * fq;
#pragma unroll
                for (int bj = 0; bj < 2; ++bj) {
                    f32x4 s0 = {0.f, 0.f, 0.f, 0.f}, s1 = {0.f, 0.f, 0.f, 0.f};
#pragma unroll
                    for (int br = 0; br < 4; ++br) { const float* q = pp + (size_t)br * 65536 + (am * 2 + bj) * 4096; s0 += __builtin_nontemporal_load((const f32x4*)q); s1 += __builtin_nontemporal_load((const f32x4*)(q + 4)); }
                    *(unsigned*)(yp + bj * 128) = pk_fp8x4(s0[0], s0[1], s0[2], s0[3]); *(unsigned*)(yp + bj * 128 + 16) = pk_fp8x4(s1[0], s1[1], s1[2], s1[3]);
                }
            }
        }
    }
    __syncthreads();
}
DI void phase_out(const Ctx& X, int l) {
    pg8::Gemm8 g{X.ws + OFF_h, X.ws + OFF_wout + (size_t)l * 1024 * 1024, 1024, 1024, 1024, 0x7C7C7C7C, 0x7C7C7C7C};
    TileSched S{l == 0 ? NRT : NB * 16, 4, X.G, X.bid, l == 0 ? 0 : 1};
    EpiOut E{X.kp->in[I_X], X.kp->in[I_CTX], (bf16_t*)(X.ws + OFF_xsb), (const float*)(X.ws + OFF_modv) + (size_t)l * 9 * 6144, l};
    pg8::gemm_phase8(X.lds, X.tid, g, S, E);
}
DI void phase_eup(const Ctx& X, int l, int vcu) {
    build_expert_tables(X, l);
    const LAS int* baseE = (const LAS int*)(X.lds + MISC_OFF + 4096); const LAS int* cntE = (const LAS int*)(X.lds + MISC_OFF + 6144);
    { const int* tokE = (const int*)(X.ws + OFF_tokE); int* tokS = (int*)(X.ws + OFF_tokS);
      for (int pr = X.bid * NTHR + X.tid; pr < T * 2; pr += X.G * NTHR) { const int row = pr >> 1; if (l > 0 && (row % TPB) < CTX) continue; tokS[pr] += baseE[tokE[pr]]; } }
    pg8::Gemm8 g{X.ws + OFF_h8, X.ws + OFF_wgu, 1024, 1024, 1024, 0x7C7C7C7C, 0x7C7C7C7C};
    ExpSchedG S{(const int*)(X.ws + OFF_xs), baseE, cntE, l > 0 ? CTX : 0, (const LAS int*)(X.lds + MISC_OFF + 4352), __builtin_amdgcn_readfirstlane(((const LAS int*)(X.lds + MISC_OFF + 4096))[33]), X.G, vcu};
    EpiUp E{X.ws + OFF_hmid};
    pg8::gemm_phase8(X.lds, X.tid, g, S, E);
}
DI void phase_edn(const Ctx& X, int l, int vcu) {
#if N_LAUNCH_PER_STEP
    build_expert_tables(X, l);
#endif
    pg8::Gemm8 g{X.ws + OFF_hmid, X.ws + OFF_wdn, 512, 512, 512, 0x7C7C7C7C, 0x7C7C7C7C};
    ExpSched S{(const LAS int*)(X.lds + MISC_OFF + 4352), __builtin_amdgcn_readfirstlane(((const LAS int*)(X.lds + MISC_OFF + 4096))[33]), X.G, vcu};
    EpiDown E{X.ws + OFF_ys};
    pg8::gemm_phase8(X.lds, X.tid, g, S, E);
}

DI int lane_id() { int x; asm volatile("v_mbcnt_lo_u32_b32 %0, -1, 0\n\tv_mbcnt_hi_u32_b32 %0, -1, %0" : "=v"(x)); return x; }
DI Ctx fresh_ctx(LAS unsigned char* lds, const int wvid) {
    KPtr kp = (KPtr)__builtin_amdgcn_kernarg_segment_ptr(); asm volatile("" : "+s"(kp));
    Ctx X; X.kp = kp; X.out = kp->out; X.ws = kp->ws; X.nsplit = kp->nsplit; X.lds = lds;
    { int t = wvid * 64 + lane_id(); asm volatile("" : "+v"(t)); X.tid = t; } X.lane = X.tid & 63; X.wv = __builtin_amdgcn_readfirstlane(X.tid >> 6);
    X.G = gridDim.x; X.bid = blockIdx.x; X.rs = T >> kp->lsplit; X.nbs = NB >> kp->lsplit; X.ctl = (unsigned*)(kp->ws + OFF_ctl);
    return X;
}
DI XcdBarrier fresh_bar(LAS unsigned char* lds) {
    KPtr kp = (KPtr)__builtin_amdgcn_kernarg_segment_ptr(); asm volatile("" : "+s"(kp));
    XcdBarrier b; b.bar = (unsigned*)(kp->ws + OFF_ctl); b.x = xb_xcc_id(); b.st = (volatile LAS unsigned*)(lds + MISC_OFF); return b;
}
#ifndef PHASE_MASK
#define PHASE_MASK 0xFFFF
#endif
__global__ void __launch_bounds__(NTHR, 2) fwd(Params p) {
    extern __shared__ __attribute__((aligned(16))) unsigned char smem[];
    LAS unsigned char* lds = (LAS unsigned char*)smem;
    if (threadIdx.x < 16) ((LAS unsigned*)(lds + MISC_OFF))[threadIdx.x] = 0u;
    __syncthreads();
    const int lo = p.step_lo, hi = p.step_hi;
    if (hi - lo > 1) (void)xcd_barrier_post((unsigned*)(p.ws + OFF_ctl), (volatile LAS unsigned*)(lds + MISC_OFF));
    const int wvid = __builtin_amdgcn_readfirstlane((int)threadIdx.x >> 6);
    int step = 0, l0 = 0, sp0 = 0;
#define STEP(k, body) do { if (step >= lo && step < hi) { if (PHASE_MASK & (1 << (k))) { const Ctx X = fresh_ctx(lds, wvid); int l = l0, sp = sp0; asm volatile("; PHASE_BEGIN " #k : "+s"(l), "+s"(sp)); (void)l; (void)sp; \
        const int vcu = (X.G % 8 == 0) ? (X.bid % 8) * (X.G / 8) + X.bid / 8 : X.bid; (void)vcu; body; asm volatile("; PHASE_END " #k); } if (step + 1 < hi) xcd_barrier(fresh_bar(lds), wvid * 64 + lane_id()); } ++step; } while (0)
#define STEPX(k, body) do { --step; if (step >= lo && step < hi) { { const Ctx X = fresh_ctx(lds, wvid); int l = l0, sp = sp0; asm volatile("; PHASEX_BEGIN " #k : "+s"(l), "+s"(sp)); (void)l; (void)sp; \
        const int vcu = (X.G % 8 == 0) ? (X.bid % 8) * (X.G / 8) + X.bid / 8 : X.bid; (void)vcu; body; } if (step + 1 < hi) xcd_barrier(fresh_bar(lds), wvid * 64 + lane_id()); } ++step; } while (0)
    STEP(0, phase_pro(X));
#if defined(REPEAT_CONV)
    STEPX(0, phase_pro(X));
#endif
    for (l0 = 0; l0 < 2; ++l0) {
        sp0 = 0;
        STEP(1, phase_pre(X, l));
#if defined(REPEAT_SMALL)
        STEPX(1, if (l == 0) phase_pre(X, l));
#endif
        for (sp0 = 0; sp0 < p.nsplit; ++sp0) {
            STEP(2, phase_inp(X, l, sp));
#if defined(REPEAT_INP)
            STEPX(2, phase_inp(X, l, sp));
#endif
            STEP(3, phase_elt(X, l));
            STEP(4, phase_mix(X, l, sp));
#if defined(REPEAT_MIXALL)
            STEPX(4, phase_mix(X, l, sp, 4, REPEAT_MIXALL));
#endif

            STEP(5, phase_cmb(X, l));
#if defined(REPEAT_SMALL)
            STEPX(5, phase_cmb(X, l));
#endif
            STEP(6, phase_mrg(X, l, sp));
#if defined(REPEAT_GEMMS) || defined(REPEAT_MRG)
            STEPX(6, phase_mrg(X, l, sp));
#endif
        }
        sp0 = 0;
        STEP(7, phase_out(X, l));
#if defined(REPEAT_OUT0)
        STEPX(7, if (l == 0) phase_out(X, l));
#endif
        STEP(8, phase_rte(X, l));

        STEP(10, phase_eup(X, l, vcu));
#if defined(REPEAT_GEMMS)
        STEPX(10, phase_eup(X, l, vcu));
#endif
        STEP(11, phase_edn(X, l, vcu));
#if defined(REPEAT_GEMMS)
        STEPX(11, phase_edn(X, l, vcu));
#endif
    }
    STEP(12, phase_fin(X));
#undef STEP
}

extern "C" void kernel_launch(void* const* d_in, const int* in_sizes, int n_in, void* d_out, int out_size, void* d_ws, size_t ws_size, hipStream_t stream) {
    static int grid = 0, nsplit = 0;
    if (grid == 0) {
        if (n_in != 25 || out_size != NB * SEQ * D) { fprintf(stderr, "kernel_launch: unexpected shapes (n_in %d, out %d)\n", n_in, out_size); grid = -1; return; }
        nsplit = 2; if (ws_need(2) > ws_size) nsplit = 4; if (ws_need(nsplit) > ws_size) nsplit = 8;
        if (ws_need(nsplit) > ws_size) { fprintf(stderr, "kernel_launch: workspace too small: %zu < %zu\n", ws_size, ws_need(nsplit)); grid = -1; return; }
        int dev = 0, cus = 0, per_cu = 0;
        if (hipGetDevice(&dev) != hipSuccess || hipDeviceGetAttribute(&cus, hipDeviceAttributeMultiprocessorCount, dev) != hipSuccess) { grid = -1; return; }
        if (hipFuncSetAttribute((const void*)fwd, hipFuncAttributeMaxDynamicSharedMemorySize, LDS_BYTES) != hipSuccess) { fprintf(stderr, "kernel_launch: hipFuncSetAttribute failed\n"); grid = -1; return; }
        if (hipOccupancyMaxActiveBlocksPerMultiprocessor(&per_cu, (const void*)fwd, NTHR, LDS_BYTES) != hipSuccess || per_cu < 1) fprintf(stderr, "kernel_launch: occupancy query says %d\n", per_cu);
        (void)hipGetLastError();
        grid = cus;
        fprintf(stderr, "kernel_launch: grid %d nsplit %d ws %zu need %zu\n", grid, nsplit, ws_size, ws_need(nsplit));
    }
    if (grid < 0) return;
    if (hipMemsetAsync(d_ws, 0, 65536, stream) != hipSuccess) return;
    Params p{};
    for (int i = 0; i < 25; ++i) p.in[i] = (const float*)d_in[i];
    p.out = (float*)d_out; p.ws = (unsigned char*)d_ws; p.nsplit = nsplit; p.lsplit = nsplit == 2 ? 1 : nsplit == 4 ? 2 : 3;
    const int nsteps = 1 + 2 * (1 + 5 * nsplit + 4) + 1;
#if N_LAUNCH_PER_STEP
    for (int s = 0; s < nsteps; ++s) { p.step_lo = s; p.step_hi = s + 1; hipLaunchKernelGGL(fwd, dim3(grid), dim3(NTHR), LDS_BYTES, stream, p); }
#else
    p.step_lo = 0; p.step_hi = nsteps; hipLaunchKernelGGL(fwd, dim3(grid), dim3(NTHR), LDS_BYTES, stream, p);
#endif
}
```
